# Optimizing an MI355X kernel written in HIP

```python
import math
import jax
import jax.numpy as jnp
from jax import lax
import numpy as np

D_MODEL = 1024
BATCH = 8
SEQ = 4096
DEPTH = 2

CTX_LEN = 256
GRID_W = 64
N_BRANCH = 4
BR_W = 512
EPS = 1e-6
CONV_W = 4
DT_MIN = 1e-3
DT_MAX = 1e-1

HG_HEADS = 4
HG_DK = BR_W // HG_HEADS
HG_CHUNK = 64
S5_GROUP = 16
S5_GROUPS = BR_W // S5_GROUP
S5_STATE = 64
LRU_BLOCKS = 8
LRU_BW = BR_W // LRU_BLOCKS
LRU_C = 8.0
M2_HEADDIM = 64
M2_HEADS = BR_W // M2_HEADDIM
M2_GROUPS = 2
M2_HPG = M2_HEADS // M2_GROUPS
M2_STATE = 64
M2_CHUNK = 64
M2_XBC = BR_W + 2 * M2_GROUPS * M2_STATE

IN_SIZES = (BR_W,) * 9 + (M2_XBC, 2 * M2_HEADS, BR_W)
IN_SPLITS = tuple(sum(IN_SIZES[:i + 1]) for i in range(len(IN_SIZES) - 1))
IN_COLS = sum(IN_SIZES)

kernel_name = 'hybrid_gated_recurrent_flow_block'


def _rms(x, w):
    xf = x.astype(jnp.float32)
    y = xf * lax.rsqrt(jnp.mean(xf * xf, axis=-1, keepdims=True) + EPS)
    return (y * w.astype(jnp.float32)).astype(x.dtype)


def _lin_comb(e1, e2):
    a1, b1 = e1
    a2, b2 = e2
    return a1 * a2, a2 * b1 + b2


def _cat_f(c, l):
    return jnp.concatenate([c, l], axis=1)


def _cat_b(c, l):
    return jnp.flip(jnp.concatenate([l, c], axis=1), axis=1)


def _uncat_b(y, n_ctx):
    y = jnp.flip(y, axis=1)
    n_lat = y.shape[1] - n_ctx
    return jnp.concatenate([y[:, n_lat:], y[:, :n_lat]], axis=1)


def _f_to_b(y, n_ctx):
    return _cat_b(y[:, :n_ctx], y[:, n_ctx:])


def _dwconv(x, w, b):
    n = x.shape[-2]
    lo = (CONV_W - 1) // 2
    pad = [(0, 0)] * (x.ndim - 2) + [(lo, CONV_W - 1 - lo), (0, 0)]
    xp = jnp.pad(x, pad)
    out = b
    for k in range(CONV_W):
        out = out + w[k] * xp[..., k:k + n, :]
    return out


def _short_conv(xc, xl, w, b):
    bsz, n_lat, ch = xl.shape
    rows = n_lat // GRID_W
    yl = _dwconv(xl.reshape(bsz, rows, GRID_W, ch), w, b).reshape(bsz, n_lat, ch)
    return _dwconv(xc, w, b), yl


def _gla_chunked(q, k, v, logf):
    bsz, T, H, _ = q.shape
    n = T // HG_CHUNK

    def r(a):
        return a.reshape(bsz, n, HG_CHUNK, H, a.shape[-1])
    q, k, v, logf = r(q), r(k), r(v), r(logf)
    b = jnp.cumsum(logf, axis=2)
    b_end = b[:, :, -1:]
    mid = 0.5 * b_end
    att = jnp.einsum('bnihk,bnjhk->bnhij', q * jnp.exp(b - mid), k * jnp.exp(mid - b))
    mask = jnp.tril(jnp.ones((HG_CHUNK, HG_CHUNK), bool))
    att = jnp.where(mask, att, 0.0)
    o_intra = jnp.einsum('bnhij,bnjhv->bnihv', att, v)
    chunk_kv = jnp.einsum('bnjhk,bnjhv->bnhkv', k * jnp.exp(b_end - b), v)
    decay = jnp.exp(b_end[:, :, 0])

    def step(s, inp):
        kv, dec = inp
        return dec[..., None] * s + kv, s
    s0 = jnp.zeros((bsz, H, k.shape[-1], v.shape[-1]), jnp.float32)
    _, s_prev = lax.scan(step, s0, (jnp.moveaxis(chunk_kv, 1, 0), jnp.moveaxis(decay, 1, 0)))
    s_prev = jnp.moveaxis(s_prev, 0, 1)
    o_inter = jnp.einsum('bnihk,bnhkv->bnihv', q * jnp.exp(b), s_prev)
    return (o_intra + o_inter).reshape(bsz, T, H, v.shape[-1])


def _hgrn2(ctx_in, lat_in, lb, norm_w):
    (cq, ci, cff, cfb, cz), (lq, li, lff, lfb, lz) = ctx_in, lat_in
    n_ctx = cq.shape[1]
    f32 = jnp.float32

    def heads(a):
        return a.reshape(a.shape[0], a.shape[1], HG_HEADS, HG_DK)

    def run(q, i, f_raw, lbd):
        f = lbd + (1.0 - lbd) * jax.nn.sigmoid(f_raw.astype(f32))
        return _gla_chunked(heads(jax.nn.silu(q.astype(f32))), heads(1.0 - f),
                            heads(i.astype(f32)), heads(jnp.log(f)))
    o = (run(_cat_f(cq, lq), _cat_f(ci, li), _cat_f(cff, lff), lb[0])
         + _uncat_b(run(_cat_b(cq, lq), _cat_b(ci, li), _cat_b(cfb, lfb), lb[1]), n_ctx))
    o = _rms(o, norm_w.reshape(HG_HEADS, HG_DK))
    o = o.reshape(o.shape[0], o.shape[1], BR_W)
    return o * jax.nn.silu(_cat_f(cz, lz).astype(f32))


def _s5(ctx_in, lat_in, a_re, a_im, log_step, b_re, b_im, c_re, c_im, d_skip, w_glu, b_glu):
    (cu, cz), (lu, lz) = ctx_in, lat_in
    n_ctx = cu.shape[1]
    f32 = jnp.float32
    u = _cat_f(cu, lu).astype(f32)
    bsz, T, _ = u.shape
    ug = u.reshape(bsz, T, S5_GROUPS, S5_GROUP).astype(jnp.complex64)
    b_mat = lax.complex(b_re.astype(f32), b_im.astype(f32))
    c_mat = lax.complex(c_re.astype(f32), c_im.astype(f32))
    bu = jnp.einsum('gnp,btgp->btgn', b_mat, ug)

    def run(bu_seq, d):
        lam = lax.complex(a_re[d].astype(f32), a_im[d].astype(f32))
        step = jnp.exp(log_step[d].astype(f32))[:, None]
        a_bar = jnp.exp(lam * step)
        drive = ((a_bar - 1.0) / lam) * bu_seq
        a_seq = jnp.broadcast_to(a_bar, (1, T) + a_bar.shape)
        _, s = lax.associative_scan(_lin_comb, (a_seq, drive), axis=1)
        return jnp.real(jnp.einsum('gpn,btgn->btgp', c_mat, s))
    y = run(bu, 0) + _uncat_b(run(_f_to_b(bu, n_ctx), 1), n_ctx)
    y = y.reshape(bsz, T, BR_W) + d_skip.astype(f32) * u
    g = jax.nn.gelu(y)
    y = g * jax.nn.sigmoid(g @ w_glu.astype(f32) + b_glu.astype(f32))
    return y * jax.nn.silu(_cat_f(cz, lz).astype(f32))


def _rglru(ctx_in, lat_in, conv_w, conv_b, gate_w, gate_b, lam):
    (cx, cz), (lx, lz) = ctx_in, lat_in
    n_ctx = cx.shape[1]
    f32 = jnp.float32
    cx, lx = _short_conv(cx, lx, conv_w, conv_b)

    def run(xs, d):
        xf = xs.astype(f32)
        bsz, T, _ = xf.shape
        xb = xf.reshape(bsz, T, LRU_BLOCKS, LRU_BW)
        gates = jax.nn.sigmoid(jnp.einsum('btnc,gncd->gbtnd', xb, gate_w[d].astype(f32))
                               + gate_b[d].astype(f32)[:, None, None])
        r = gates[0].reshape(bsz, T, BR_W)
        i = gates[1].reshape(bsz, T, BR_W)
        log_a = -LRU_C * r * jax.nn.softplus(-lam[d].astype(f32))
        b = jnp.sqrt(-jnp.expm1(2.0 * log_a)) * (i * xf)
        _, h = lax.associative_scan(_lin_comb, (jnp.exp(log_a), b), axis=1)
        return h
    h = run(_cat_f(cx, lx), 0) + _uncat_b(run(_cat_b(cx, lx), 1), n_ctx)
    return h * jax.nn.silu(_cat_f(cz, lz).astype(f32))


def _ssd_chunked(x, dt, a, bm, cm):
    bsz, T = x.shape[:2]
    n = T // M2_CHUNK

    def r(t):
        return t.reshape((bsz, n, M2_CHUNK) + t.shape[2:])
    x, dt, bm, cm = r(x), r(dt), r(bm), r(cm)
    cum = jnp.cumsum(dt * a, axis=2)
    seg = cum[:, :, :, None] - cum[:, :, None, :]
    mask = jnp.tril(jnp.ones((M2_CHUNK, M2_CHUNK), bool))[:, :, None, None]
    decay_ij = jnp.exp(jnp.where(mask, seg, -jnp.inf))
    scores = jnp.einsum('bcigs,bcjgs->bcijg', cm, bm)
    w = scores[..., None] * decay_ij * dt[:, :, None]
    y_intra = jnp.einsum('bcijgr,bcjgrp->bcigrp', w, x)
    cum_end = cum[:, :, -1]
    wx = (jnp.exp(cum_end[:, :, None] - cum) * dt)[..., None] * x
    chunk_state = jnp.einsum('bcjgs,bcjgrp->bcgrps', bm, wx)

    def step(s, inp):
        st, dec = inp
        return dec[..., None, None] * s + st, s
    s0 = jnp.zeros(chunk_state.shape[:1] + chunk_state.shape[2:], jnp.float32)
    _, s_prev = lax.scan(step, s0, (jnp.moveaxis(chunk_state, 1, 0), jnp.moveaxis(jnp.exp(cum_end), 1, 0)))
    s_prev = jnp.moveaxis(s_prev, 0, 1)
    y_inter = jnp.einsum('bcigs,bcgrps->bcigrp', cm, s_prev) * jnp.exp(cum)[..., None]
    return (y_intra + y_inter).reshape(bsz, T, M2_GROUPS, M2_HPG, M2_HEADDIM)


def _mamba2(ctx_in, lat_in, conv_w, conv_b, dt_bias, a_log, d_skip, norm_w):
    (cxbc, cdt, cz), (lxbc, ldt, lz) = ctx_in, lat_in
    n_ctx = cxbc.shape[1]
    f32 = jnp.float32
    cxbc, lxbc = _short_conv(cxbc, lxbc, conv_w, conv_b)
    cxbc, lxbc = jax.nn.silu(cxbc.astype(f32)), jax.nn.silu(lxbc.astype(f32))
    gn = M2_GROUPS * M2_STATE

    def run(xbc, dt_raw, d):
        bsz, T, _ = xbc.shape
        xs = xbc[..., :BR_W].reshape(bsz, T, M2_GROUPS, M2_HPG, M2_HEADDIM)
        bm = xbc[..., BR_W:BR_W + gn].reshape(bsz, T, M2_GROUPS, M2_STATE)
        cm = xbc[..., BR_W + gn:].reshape(bsz, T, M2_GROUPS, M2_STATE)
        dt = jax.nn.softplus(dt_raw.astype(f32) + dt_bias[d].astype(f32)).reshape(bsz, T, M2_GROUPS, M2_HPG)
        a = -jnp.exp(a_log[d].astype(f32)).reshape(M2_GROUPS, M2_HPG)
        return _ssd_chunked(xs, dt, a, bm, cm)
    xbc_f = _cat_f(cxbc, lxbc)
    y = (run(xbc_f, _cat_f(cdt[..., :M2_HEADS], ldt[..., :M2_HEADS]), 0)
         + _uncat_b(run(_cat_b(cxbc, lxbc), _cat_b(cdt[..., M2_HEADS:], ldt[..., M2_HEADS:]), 1), n_ctx))
    bsz, T, _ = xbc_f.shape
    skip = d_skip.astype(f32)[:, None] * xbc_f[..., :BR_W].reshape(bsz, T, M2_HEADS, M2_HEADDIM)
    y = y.reshape(bsz, T, BR_W) + skip.reshape(bsz, T, BR_W)
    return _rms(y * jax.nn.silu(_cat_f(cz, lz).astype(f32)), norm_w)


def _merge(h, ys, w_gate, b_gate, w_branch):
    out = jax.nn.sigmoid(h @ w_gate[0] + b_gate[0]) * (ys[0].astype(h.dtype) @ w_branch[0])
    for k in range(1, N_BRANCH):
        out = out + jax.nn.sigmoid(h @ w_gate[k] + b_gate[k]) * (ys[k].astype(h.dtype) @ w_branch[k])
    return out


def setup_inputs(seed: int = 0) -> dict:
    key = jax.random.key(seed)
    ks = iter(jax.random.split(key, 48))
    f32 = jnp.float32

    def nrm(shape, s=1.0):
        return s * jax.random.normal(next(ks), shape, f32)

    def uni(shape, lo, hi):
        return jax.random.uniform(next(ks), shape, f32, lo, hi)
    L = DEPTH
    dt_m2 = jnp.exp(uni((L, 2, M2_HEADS), math.log(DT_MIN), math.log(DT_MAX)))
    lru_a = uni((L, 2, BR_W), 0.9, 0.999) ** (1.0 / LRU_C)
    return {
        'x': nrm((BATCH, SEQ, D_MODEL)),
        'c': nrm((BATCH, D_MODEL)),
        'ctx': nrm((BATCH, CTX_LEN, D_MODEL)),
        'c_ctx': nrm((D_MODEL,)),
        'norm_w': 1.0 + nrm((L, D_MODEL), 0.02),
        'w_mod': nrm((L, D_MODEL, 3 * D_MODEL), 0.5 * D_MODEL ** -0.5),
        'b_mod': nrm((L, 3 * D_MODEL), 0.01),
        'w_in': nrm((L, D_MODEL, IN_COLS), D_MODEL ** -0.5),
        'hg_lb_logits': nrm((L + 1, 2, BR_W), 0.1),
        'hg_norm': 1.0 + nrm((L, BR_W), 0.02),
        's5_a_re': -0.5 + nrm((L, 2, S5_GROUPS, S5_STATE), 0.01),
        's5_a_im': math.pi * jnp.arange(S5_STATE, dtype=f32) + nrm((L, 2, S5_GROUPS, S5_STATE), 0.01),
        's5_log_step': uni((L, 2, S5_GROUPS), math.log(DT_MIN), math.log(DT_MAX)),
        's5_b_re': nrm((L, S5_GROUPS, S5_STATE, S5_GROUP), (2 * S5_GROUP) ** -0.5),
        's5_b_im': nrm((L, S5_GROUPS, S5_STATE, S5_GROUP), (2 * S5_GROUP) ** -0.5),
        's5_c_re': nrm((L, S5_GROUPS, S5_GROUP, S5_STATE), S5_STATE ** -0.5),
        's5_c_im': nrm((L, S5_GROUPS, S5_GROUP, S5_STATE), S5_STATE ** -0.5),
        's5_d': nrm((L, BR_W)),
        's5_w_glu': nrm((L, BR_W, BR_W), BR_W ** -0.5),
        's5_b_glu': nrm((L, BR_W), 0.01),
        'lru_conv_w': nrm((L, CONV_W, BR_W), CONV_W ** -0.5),
        'lru_conv_b': nrm((L, BR_W), 0.01),
        'lru_gate_w': nrm((L, 2, 2, LRU_BLOCKS, LRU_BW, LRU_BW), LRU_BW ** -0.5),
        'lru_gate_b': nrm((L, 2, 2, LRU_BLOCKS, LRU_BW), 0.01),
        'lru_lam': jnp.log(lru_a) - jnp.log1p(-lru_a),
        'm2_conv_w': nrm((L, CONV_W, M2_XBC), CONV_W ** -0.5),
        'm2_conv_b': nrm((L, M2_XBC), 0.01),
        'm2_dt_bias': dt_m2 + jnp.log(-jnp.expm1(-dt_m2)),
        'm2_a_log': jnp.log(uni((L, 2, M2_HEADS), 1.0, 16.0)),
        'm2_d': 1.0 + nrm((L, M2_HEADS), 0.02),
        'm2_norm': 1.0 + nrm((L, BR_W), 0.02),
        'w_branch': nrm((L, N_BRANCH, BR_W, D_MODEL), BR_W ** -0.5),
        'w_gate': nrm((L, N_BRANCH, D_MODEL, D_MODEL), D_MODEL ** -0.5),
        'b_gate': nrm((L, N_BRANCH, D_MODEL), 0.01),
        'w_out': nrm((L, D_MODEL, D_MODEL), D_MODEL ** -0.5),
        'final_norm': 1.0 + nrm((D_MODEL,), 0.02),
    }


def reference(x, c, ctx, c_ctx, norm_w, w_mod, b_mod, w_in, hg_lb_logits, hg_norm,
              s5_a_re, s5_a_im, s5_log_step, s5_b_re, s5_b_im, s5_c_re, s5_c_im, s5_d, s5_w_glu, s5_b_glu,
              lru_conv_w, lru_conv_b, lru_gate_w, lru_gate_b, lru_lam,
              m2_conv_w, m2_conv_b, m2_dt_bias, m2_a_log, m2_d, m2_norm,
              w_branch, w_gate, b_gate, w_out, final_norm):
    n_ctx = ctx.shape[1]
    lb_all = jnp.cumsum(jax.nn.softmax(hg_lb_logits.astype(jnp.float32), axis=0), axis=0)
    for l in range(DEPTH):
        mod = jax.nn.silu(c) @ w_mod[l] + b_mod[l]
        mod_c = jax.nn.silu(c_ctx) @ w_mod[l] + b_mod[l]
        sh, sc, gt = jnp.split(mod[:, None, :], 3, axis=-1)
        sh_c, sc_c, gt_c = jnp.split(mod_c, 3, axis=-1)
        h = _rms(x, norm_w[l]) * (1.0 + sc) + sh
        hc = _rms(ctx, norm_w[l]) * (1.0 + sc_c) + sh_c
        u = jnp.split(h @ w_in[l], IN_SPLITS, axis=-1)
        uc = jnp.split(hc @ w_in[l], IN_SPLITS, axis=-1)
        ys = (
            _hgrn2(uc[0:5], u[0:5], lb_all[l], hg_norm[l]),
            _s5(uc[5:7], u[5:7], s5_a_re[l], s5_a_im[l], s5_log_step[l], s5_b_re[l], s5_b_im[l],
                s5_c_re[l], s5_c_im[l], s5_d[l], s5_w_glu[l], s5_b_glu[l]),
            _rglru(uc[7:9], u[7:9], lru_conv_w[l], lru_conv_b[l], lru_gate_w[l], lru_gate_b[l], lru_lam[l]),
            _mamba2(uc[9:12], u[9:12], m2_conv_w[l], m2_conv_b[l], m2_dt_bias[l], m2_a_log[l], m2_d[l], m2_norm[l]),
        )
        x_new = x + gt * (_merge(h, [y[:, n_ctx:] for y in ys], w_gate[l], b_gate[l], w_branch[l]) @ w_out[l])
        if l < DEPTH - 1:
            ctx = ctx + gt_c * (_merge(hc, [y[:, :n_ctx] for y in ys], w_gate[l], b_gate[l], w_branch[l]) @ w_out[l])
        x = x_new
    return _rms(x, final_norm)
```

```cpp
#include <hip/hip_runtime.h>
#include <hip/hip_bf16.h>
#include <hip/hip_cooperative_groups.h>
#include <cstdio>
namespace cg = cooperative_groups;

typedef unsigned short bf16_t;
typedef __attribute__((ext_vector_type(8))) short bf16x8;
typedef __attribute__((ext_vector_type(4))) float f32x4;
typedef __attribute__((ext_vector_type(16))) float f32x16;

#define DM 1024
#define NB 8
#define SEQ 4096
#define CTXL 256
#define TT 4352
#define NTOK (NB * TT)
#define GB 4
#define NGRP 2
#define RG (GB * TT)
#define NTILE 68
#define UC 11136
#define NIN 6016
#define EPS 1e-6f

#define C_HQ 0
#define C_HI 512
#define C_HFF 1024
#define C_HFB 1536
#define C_HZ 2048
#define C_SU 2560
#define C_SZ 3072
#define C_LX 3584
#define C_LZ 4096
#define C_MX 4608
#define C_MZ 5376
#define C_MDT 5888
#define Y_HF 6016
#define Y_HB 6528
#define Y_SF 7040
#define Y_SB 7552
#define Y_LF 8064
#define Y_LB 8576
#define Y_MF 9088
#define Y_MB 9600
#define L_LAF 10112
#define L_LAB 10624

#define W_IN_OFF 0
#define W_G_OFF (NIN * 1024)
#define W_B_OFF (W_G_OFF + 4096 * 1024)
#define W_O_OFF (W_B_OFF + 4 * 1024 * 512)
#define W_GLU_OFF (W_O_OFF + 1024 * 1024)
#define W_LAYER (W_GLU_OFF + 512 * 512)

#define SMEM_BYTES 75776

struct Params {
  const float *x, *c, *ctx, *c_ctx, *norm_w, *w_mod, *b_mod, *w_in, *hg_lb_logits, *hg_norm,
      *s5_a_re, *s5_a_im, *s5_log_step, *s5_b_re, *s5_b_im, *s5_c_re, *s5_c_im, *s5_d, *s5_w_glu, *s5_b_glu,
      *lru_conv_w, *lru_conv_b, *lru_gate_w, *lru_gate_b, *lru_lam,
      *m2_conv_w, *m2_conv_b, *m2_dt_bias, *m2_a_log, *m2_d, *m2_norm,
      *w_branch, *w_gate, *b_gate, *w_out, *final_norm;
  float* out;
  bf16_t* U;
  bf16_t* H;
  bf16_t* W;
  float* ctx1;
  float* mod;
  float* lb;
  float* s5p;
  bf16_t* Wlru;
  unsigned* bar;
  bf16_t* KS;
  float* EM;
};

__device__ __forceinline__ bf16_t f2bf(float f) {
  unsigned u = __float_as_uint(f);
  u += 0x7fffu + ((u >> 16) & 1u);
  return (bf16_t)(u >> 16);
}
typedef __attribute__((ext_vector_type(2))) float f32x2_t;
typedef __attribute__((ext_vector_type(2))) __bf16 bf16x2_t;
__device__ __forceinline__ unsigned pack2bf(float a, float b) {
  f32x2_t v = {a, b};
  bf16x2_t r = __builtin_convertvector(v, bf16x2_t);
  return *(unsigned*)&r;
}
__device__ __forceinline__ float bf2f(bf16_t h) { return __uint_as_float(((unsigned)h) << 16); }
__device__ __forceinline__ float sigmoidf_(float x) { return 1.f / (1.f + __expf(-x)); }
__device__ __forceinline__ float siluf_(float x) { return x / (1.f + __expf(-x)); }
__device__ __forceinline__ float softplusf_(float x) { return x > 20.f ? x : log1pf(__expf(x)); }
__device__ __forceinline__ float geluf_(float y) {
  return 0.5f * y * (1.f + tanhf(0.7978845608028654f * (y + 0.044715f * y * y * y)));
}
__device__ __forceinline__ int tid_opaque() {
  int t = threadIdx.x;
  asm volatile("" : "+v"(t));
  return t;
}
typedef __attribute__((ext_vector_type(4))) float nt_f4;
typedef __attribute__((ext_vector_type(4))) unsigned nt_u4;
__device__ __forceinline__ float4 ld_nt_f4(const float* p) {
  nt_f4 v = __builtin_nontemporal_load((const nt_f4*)p);
  return make_float4(v.x, v.y, v.z, v.w);
}
__device__ __forceinline__ void st_nt_f4(float* p, float4 o) {
  nt_f4 v = {o.x, o.y, o.z, o.w};
  __builtin_nontemporal_store(v, (nt_f4*)p);
}
__device__ __forceinline__ uint4 ld_nt_u4(const bf16_t* p) {
  nt_u4 v = __builtin_nontemporal_load((const nt_u4*)p);
  return make_uint4(v.x, v.y, v.z, v.w);
}
__device__ __forceinline__ int tile_of(int c, int d) { return d == 0 ? c : (c < 4 ? 3 - c : 71 - c); }

__device__ __forceinline__ void load8(const bf16_t* p, float (&v)[8]) {
  uint4 r = *(const uint4*)p;
  unsigned w[4] = {r.x, r.y, r.z, r.w};
#pragma unroll
  for (int i = 0; i < 4; i++) {
    v[2 * i] = __uint_as_float(w[i] << 16);
    v[2 * i + 1] = __uint_as_float(w[i] & 0xffff0000u);
  }
}
__device__ __forceinline__ void store8(bf16_t* p, const float (&v)[8]) {
  uint4 r;
  r.x = (unsigned)f2bf(v[0]) | ((unsigned)f2bf(v[1]) << 16);
  r.y = (unsigned)f2bf(v[2]) | ((unsigned)f2bf(v[3]) << 16);
  r.z = (unsigned)f2bf(v[4]) | ((unsigned)f2bf(v[5]) << 16);
  r.w = (unsigned)f2bf(v[6]) | ((unsigned)f2bf(v[7]) << 16);
  *(uint4*)p = r;
}

#define GSTR 40
template <int TMW, int TN, bool PL = true>
__device__ __forceinline__ void gemm_main(const bf16_t* __restrict__ A, int lda, const bf16_t* __restrict__ Bt,
                                          int ldb, int K, f32x16 (&acc)[TMW][TN], unsigned char* smem) {
  constexpr int BM = 64 * TMW, BN = 64 * TN;
  bf16_t* As = (bf16_t*)smem;
  bf16_t* Bs = As + 2 * BM * GSTR;
  const int tid = tid_opaque(), lane = tid & 63, wave = tid >> 6;
  const int wm = wave >> 1, wn = wave & 1;
  const int lr = tid >> 2, lc = (tid & 3) * 8;
  const unsigned aoff = (unsigned)(lr * lda + lc), boff = (unsigned)(lr * ldb + lc);
  const bf16_t* A2 = A + (size_t)64 * lda;
  const bf16_t* A3 = A + (size_t)128 * lda;
  const bf16_t* A4 = A + (size_t)192 * lda;
  const bf16_t* B2 = Bt + (size_t)64 * ldb;
  uint4 pa0, pa1, pa2, pa3, pb0, pb1, qa0, qa1, qa2, qa3, qb0, qb1;
  const int r32 = lane & 31, kh = (lane >> 5) * 8;
  const int KT = K / 32;
#define G_LOAD(R, k0)                                    \
  R##a0 = *(const uint4*)(A + (aoff + (k0)));            \
  R##a1 = *(const uint4*)(A2 + (aoff + (k0)));           \
  if (TMW == 4) {                                        \
    R##a2 = *(const uint4*)(A3 + (aoff + (k0)));         \
    R##a3 = *(const uint4*)(A4 + (aoff + (k0)));         \
  }                                                      \
  R##b0 = *(const uint4*)(Bt + (boff + (k0)));           \
  if (TN == 2) R##b1 = *(const uint4*)(B2 + (boff + (k0)));
#define G_STORE(R, buf)                                                   \
  *(uint4*)(As + ((buf)*BM + lr) * GSTR + lc) = R##a0;                    \
  *(uint4*)(As + ((buf)*BM + lr + 64) * GSTR + lc) = R##a1;               \
  if (TMW == 4) {                                                         \
    *(uint4*)(As + ((buf)*BM + lr + 128) * GSTR + lc) = R##a2;            \
    *(uint4*)(As + ((buf)*BM + lr + 192) * GSTR + lc) = R##a3;            \
  }                                                                       \
  *(uint4*)(Bs + ((buf)*BN + lr) * GSTR + lc) = R##b0;                    \
  if (TN == 2) *(uint4*)(Bs + ((buf)*BN + lr + 64) * GSTR + lc) = R##b1;
#define G_COMPUTE(buf)                                                                                        \
  if (PL) {                                                                                                   \
    bf16x8 bfr[2][TN], afr[2][TMW];                                                                           \
    _Pragma("unroll") for (int ks = 0; ks < 2; ks++) {                                                        \
      _Pragma("unroll") for (int jn = 0; jn < TN; jn++)                                                       \
        bfr[ks][jn] = *(const bf16x8*)(Bs + ((buf)*BN + wn * 32 * TN + jn * 32 + r32) * GSTR + ks * 16 + kh); \
      _Pragma("unroll") for (int im = 0; im < TMW; im++)                                                      \
        afr[ks][im] = *(const bf16x8*)(As + ((buf)*BM + wm * 32 * TMW + im * 32 + r32) * GSTR + ks * 16 + kh); \
    }                                                                                                         \
    _Pragma("unroll") for (int ks = 0; ks < 2; ks++)                                                          \
      _Pragma("unroll") for (int im = 0; im < TMW; im++)                                                      \
        _Pragma("unroll") for (int jn = 0; jn < TN; jn++)                                                     \
          acc[im][jn] = __builtin_amdgcn_mfma_f32_32x32x16_bf16(afr[ks][im], bfr[ks][jn], acc[im][jn], 0, 0, 0); \
  } else {                                                                                                    \
    _Pragma("unroll") for (int ks = 0; ks < 2; ks++) {                                                        \
      bf16x8 bfr[TN];                                                                                         \
      _Pragma("unroll") for (int jn = 0; jn < TN; jn++)                                                       \
        bfr[jn] = *(const bf16x8*)(Bs + ((buf)*BN + wn * 32 * TN + jn * 32 + r32) * GSTR + ks * 16 + kh);     \
      _Pragma("unroll") for (int im = 0; im < TMW; im++) {                                                    \
        bf16x8 af = *(const bf16x8*)(As + ((buf)*BM + wm * 32 * TMW + im * 32 + r32) * GSTR + ks * 16 + kh);  \
        _Pragma("unroll") for (int jn = 0; jn < TN; jn++)                                                     \
          acc[im][jn] = __builtin_amdgcn_mfma_f32_32x32x16_bf16(af, bfr[jn], acc[im][jn], 0, 0, 0);           \
      }                                                                                                       \
    }                                                                                                         \
  }
  __syncthreads();
  G_LOAD(p, 0)
  G_LOAD(q, 32)
  G_STORE(p, 0)
  __syncthreads();
  for (int kt = 0; kt < KT; kt += 2) {
    if (kt + 2 < KT) { G_LOAD(p, (kt + 2) * 32) }
    G_COMPUTE(0)
    G_STORE(q, 1)
    __syncthreads();
    if (kt + 3 < KT) { G_LOAD(q, (kt + 3) * 32) }
    G_COMPUTE(1)
    if (kt + 2 < KT) { G_STORE(p, 0) }
    __syncthreads();
  }
#undef G_LOAD
#undef G_STORE
#undef G_COMPUTE
}

template <int TMW, int TN>
__device__ __forceinline__ void acc_zero(f32x16 (&acc)[TMW][TN]) {
#pragma unroll
  for (int i = 0; i < TMW; i++)
#pragma unroll
    for (int j = 0; j < TN; j++)
#pragma unroll
      for (int r = 0; r < 16; r++) acc[i][j][r] = 0.f;
}

#define ACC_ROWM(TMW, i, reg) ((tid >> 7) * 32 * (TMW) + (i)*32 + ((reg)&3) + 8 * ((reg) >> 2) + 4 * ((tid & 63) >> 5))
#define ACC_ROW(i, reg) ACC_ROWM(2, i, reg)
#define ACC_COL(TN, jn) (((tid >> 6) & 1) * 32 * (TN) + (jn)*32 + (tid & 31))

__device__ __forceinline__ int win_srccol(int n) {
  if (n < 5376) return n;
  if (n < 5888) return n + 16;
  if (n < 5904) return n - 512;
  return -1;
}

__device__ void transpose_item(const float* __restrict__ src, int src_ld, bf16_t* __restrict__ dst, int dst_ld, int k0,
                               int n0, int mode, float* tile) {
  const int tid = tid_opaque();
  __syncthreads();
  for (int e = tid; e < 4096; e += 256) {
    int i = e >> 6, j = e & 63;
    int n = n0 + j;
    int sc = mode ? win_srccol(n) : n;
    tile[i * 65 + j] = sc >= 0 ? src[(size_t)(k0 + i) * src_ld + sc] : 0.f;
  }
  __syncthreads();
  for (int e = tid; e < 4096; e += 256) {
    int j = e >> 6, i = e & 63;
    dst[(size_t)(n0 + j) * dst_ld + k0 + i] = f2bf(tile[i * 65 + j]);
  }
}

__device__ void phase0(const Params& p, unsigned char* smem) {
  float* fs = (float*)smem;
  const int tid = tid_opaque();
  const int NT_L = 3360;
  const int n_tr = 2 * NT_L;
  const int n_mod = 384, n_lb = 4, n_s5 = 32, n_lw = 64;
  const int total = n_tr + n_mod + n_lb + n_s5 + n_lw;
  for (int it = blockIdx.x; it < total; it += gridDim.x) {
    if (it < n_tr) {
      int l = it / NT_L, idx = it % NT_L;
      bf16_t* Wl = p.W + (size_t)l * W_LAYER;
      if (idx < 1504) {
        int kt = idx % 16, nt = idx / 16;
        transpose_item(p.w_in + (size_t)l * 1024 * 5904, 5904, Wl + W_IN_OFF, 1024, kt * 64, nt * 64, 1, fs);
      } else if ((idx -= 1504) < 1024) {
        int kb = idx / 256, rem = idx % 256, kt = rem % 16, nt = rem / 16;
        transpose_item(p.w_gate + (size_t)(l * 4 + kb) * 1024 * 1024, 1024, Wl + W_G_OFF + (size_t)kb * 1024 * 1024,
                       1024, kt * 64, nt * 64, 0, fs);
      } else if ((idx -= 1024) < 512) {
        int kb = idx / 128, rem = idx % 128, kt = rem % 8, nt = rem / 8;
        transpose_item(p.w_branch + (size_t)(l * 4 + kb) * 512 * 1024, 1024, Wl + W_B_OFF + (size_t)kb * 1024 * 512,
                       512, kt * 64, nt * 64, 0, fs);
      } else if ((idx -= 512) < 256) {
        int kt = idx % 16, nt = idx / 16;
        transpose_item(p.w_out + (size_t)l * 1024 * 1024, 1024, Wl + W_O_OFF, 1024, kt * 64, nt * 64, 0, fs);
      } else {
        idx -= 256;
        int kt = idx % 8, nt = idx / 8;
        transpose_item(p.s5_w_glu + (size_t)l * 512 * 512, 512, Wl + W_GLU_OFF, 512, kt * 64, nt * 64, 0, fs);
      }
    } else if (it < n_tr + n_mod) {
      int m = it - n_tr;
      int l = m / 192, cb = m % 192;
      float* sc = fs;
      float* red = fs + 9 * 1024;
      __syncthreads();
      for (int e = tid; e < 9 * 1024; e += 256) {
        int r = e >> 10, k = e & 1023;
        float v = r < 8 ? p.c[r * 1024 + k] : p.c_ctx[k];
        sc[e] = siluf_(v);
      }
      __syncthreads();
      int cl = tid & 15, kq = tid >> 4;
      int col = cb * 16 + cl;
      float a[9];
#pragma unroll
      for (int r = 0; r < 9; r++) a[r] = 0.f;
      const float* wp = p.w_mod + (size_t)l * 1024 * 3072 + col;
#pragma unroll 8
      for (int k = kq * 64; k < kq * 64 + 64; k++) {
        float w = wp[(size_t)k * 3072];
#pragma unroll
        for (int r = 0; r < 9; r++) a[r] += sc[r * 1024 + k] * w;
      }
#pragma unroll
      for (int r = 0; r < 9; r++) red[(kq * 9 + r) * 16 + cl] = a[r];
      __syncthreads();
      if (tid < 144) {
        int r = tid >> 4, c2 = tid & 15;
        float sacc = 0.f;
#pragma unroll
        for (int q = 0; q < 16; q++) sacc += red[(q * 9 + r) * 16 + c2];
        int cc = cb * 16 + c2;
        p.mod[(size_t)(l * 9 + r) * 3072 + cc] = sacc + p.b_mod[l * 3072 + cc];
      }
    } else if (it < n_tr + n_mod + n_lb) {
      int q = (it - n_tr - n_mod) * 256 + tid;
      float x0 = p.hg_lb_logits[q], x1 = p.hg_lb_logits[1024 + q], x2 = p.hg_lb_logits[2048 + q];
      float mx = fmaxf(x0, fmaxf(x1, x2));
      float e0 = expf(x0 - mx), e1 = expf(x1 - mx), e2 = expf(x2 - mx);
      float s = e0 + e1 + e2;
      p.lb[q] = e0 / s;
      p.lb[1024 + q] = (e0 + e1) / s;
    } else if (it >= n_tr + n_mod + n_lb + n_s5) {
      int idx = it - (n_tr + n_mod + n_lb + n_s5);
      transpose_item(p.lru_gate_w + (size_t)idx * 4096, 64, p.Wlru + (size_t)idx * 4096, 64, 0, 0, 0, fs);
    } else {
      int q = (it - n_tr - n_mod - n_lb) * 256 + tid;
      int n = q & 63, g = (q >> 6) & 31, d = (q >> 11) & 1, l = q >> 12;
      int ai = ((l * 2 + d) * 32 + g) * 64 + n;
      float are = p.s5_a_re[ai], aim = p.s5_a_im[ai];
      float step = expf(p.s5_log_step[(l * 2 + d) * 32 + g]);
      float mag = expf(are * step);
      float sn, cs;
      sincosf(aim * step, &sn, &cs);
      float abr = mag * cs, abi = mag * sn;
      float nr = abr - 1.f, ni = abi;
      float den = are * are + aim * aim;
      float cr = (nr * are + ni * aim) / den;
      float ci = (ni * are - nr * aim) / den;
      float* o = p.s5p + (size_t)q * 34;
      o[0] = abr;
      o[1] = abi;
      const float* bre = p.s5_b_re + ((size_t)(l * 32 + g) * 64 + n) * 16;
      const float* bim = p.s5_b_im + ((size_t)(l * 32 + g) * 64 + n) * 16;
      for (int pp = 0; pp < 16; pp++) {
        float br = bre[pp], bi = bim[pp];
        o[2 + pp] = cr * br - ci * bi;
        o[18 + pp] = cr * bi + ci * br;
      }
    }
  }
}

__device__ void phase_norm(const Params& p, int l, int g) {
  const int tid = tid_opaque();
  const int lane = tid & 63, wave = tid >> 6;
  const float* nw = p.norm_w + l * 1024;
  for (int it = blockIdx.x; it < RG / 4; it += gridDim.x) {
    int rl = it * 4 + wave;
    int r = g * RG + rl;
    int b = r / TT, t = r % TT;
    const float* src;
    const float* md;
    if (t < CTXL) {
      src = (l == 0 ? p.ctx : p.ctx1) + (size_t)(b * CTXL + t) * 1024;
      md = p.mod + (size_t)(l * 9 + 8) * 3072;
    } else {
      src = (l == 0 ? p.x : p.out) + (size_t)(b * SEQ + t - CTXL) * 1024;
      md = p.mod + (size_t)(l * 9 + b) * 3072;
    }
    float4 v[4];
    float ss = 0.f;
#pragma unroll
    for (int i = 0; i < 4; i++) {
      v[i] = *(const float4*)(src + i * 256 + lane * 4);
      ss += v[i].x * v[i].x + v[i].y * v[i].y + v[i].z * v[i].z + v[i].w * v[i].w;
    }
#pragma unroll
    for (int m = 1; m < 64; m <<= 1) ss += __shfl_xor(ss, m);
    float rstd = rsqrtf(ss * (1.f / 1024.f) + EPS);
    bf16_t* dst = p.H + (size_t)rl * 1024;
#pragma unroll
    for (int i = 0; i < 4; i++) {
      int c0 = i * 256 + lane * 4;
      float4 w = *(const float4*)(nw + c0);
      float4 sh = *(const float4*)(md + c0);
      float4 sc = *(const float4*)(md + 1024 + c0);
      float o0 = v[i].x * rstd * w.x * (1.f + sc.x) + sh.x;
      float o1 = v[i].y * rstd * w.y * (1.f + sc.y) + sh.y;
      float o2 = v[i].z * rstd * w.z * (1.f + sc.z) + sh.z;
      float o3 = v[i].w * rstd * w.w * (1.f + sc.w) + sh.w;
      uint2 pk;
      pk.x = (unsigned)f2bf(o0) | ((unsigned)f2bf(o1) << 16);
      pk.y = (unsigned)f2bf(o2) | ((unsigned)f2bf(o3) << 16);
      *(uint2*)(dst + c0) = pk;
    }
  }
}

template <int TMW>
__device__ __forceinline__ void inproj_tile(const Params& p, int l, int tm, int ct, unsigned char* smem) {
  const int tid = tid_opaque();
  const bf16_t* Wt = p.W + (size_t)l * W_LAYER + W_IN_OFF;
  f32x16 acc[TMW][2];
  acc_zero<TMW, 2>(acc);
  gemm_main<TMW, 2>(p.H + (size_t)tm * (64 * TMW) * 1024, 1024, Wt + (size_t)ct * 128 * 1024, 1024, 1024, acc, smem);
#pragma unroll
  for (int i = 0; i < TMW; i++)
#pragma unroll
    for (int jn = 0; jn < 2; jn++)
#pragma unroll
      for (int reg = 0; reg < 16; reg++) {
        int row = tm * (64 * TMW) + ACC_ROWM(TMW, i, reg), col = ct * 128 + ACC_COL(2, jn);
        p.U[(unsigned)(row * UC + col)] = f2bf(acc[i][jn][reg]);
      }
}

__device__ void phase_inproj(const Params& p, int l, int g, unsigned char* smem) {
  const int ntm = RG / 128;
  for (int it = blockIdx.x; it < 31 * ntm; it += gridDim.x) {
    const int tm = it % ntm, ci = it / ntm;
    const int ct = ci < 16 ? ci : (ci < 20 ? ci + 4 : (ci < 24 ? ci + 8 : (ci < 30 ? ci + 12 : 46)));
    inproj_tile<2>(p, l, tm, ct, smem);
  }
  (void)g;
}

__device__ void zgate_tiles(const Params& p, int l, unsigned* ctr, unsigned char* smem) {
  __shared__ int zt_next;
  const int ntm = RG / 256;
  for (;;) {
    __syncthreads();
    if (threadIdx.x == 0) zt_next = (int)atomicAdd(ctr, 1u);
    __syncthreads();
    const int t = zt_next;
    if (t >= 16 * ntm) break;
    const int tm = t % ntm, zi = t / ntm;
    const int mix = zi >> 2;
    const int ct = (mix == 0 ? 16 : (mix == 1 ? 24 : (mix == 2 ? 32 : 42))) + (zi & 3);
    inproj_tile<4>(p, l, tm, ct, smem);
  }
}

template <int N>
__device__ __forceinline__ void rs_step(const float (&in)[2 * N], float (&out)[N], int bit, bool up) {
#pragma unroll
  for (int i = 0; i < N; i++) {
    float send = up ? in[i] : in[i + N];
    float keep = up ? in[i + N] : in[i];
    out[i] = keep + __shfl_xor(send, bit);
  }
}

__device__ __forceinline__ void unpack8(const uint4& r, float (&v)[8]) {
  v[0] = __uint_as_float(r.x << 16); v[1] = __uint_as_float(r.x & 0xffff0000u);
  v[2] = __uint_as_float(r.y << 16); v[3] = __uint_as_float(r.y & 0xffff0000u);
  v[4] = __uint_as_float(r.z << 16); v[5] = __uint_as_float(r.z & 0xffff0000u);
  v[6] = __uint_as_float(r.w << 16); v[7] = __uint_as_float(r.w & 0xffff0000u);
}

__device__ __forceinline__ bf16x8 pack_bf16x8(const float (&v)[8]) {
  uint4 t = make_uint4(pack2bf(v[0], v[1]), pack2bf(v[2], v[3]), pack2bf(v[4], v[5]), pack2bf(v[6], v[7]));
  return *(bf16x8*)&t;
}

__device__ void hg_prep(const Params& p, int l, int item, unsigned char* smem) {
  const int c = item % NTILE;
  const int rr = item / NTILE;
  const int hh = rr & 3, d = (rr >> 2) & 1, bl = rr >> 3;
  const int tid = tid_opaque();
  const int kk = tid & 127, half = tid >> 7;
  float* ex = (float*)smem;
  const int tau = tile_of(c, d);
  bf16_t* U = p.U + (size_t)bl * TT * UC;
  bf16_t* KSb = p.KS + (size_t)bl * TT * 1024 + d * 512 + hh * 128 + kk;
  const int qcol = C_HQ + hh * 128 + kk, fcol = (d == 0 ? C_HFF : C_HFB) + hh * 128 + kk;
  const float lbv = p.lb[(l * 2 + d) * 512 + hh * 128 + kk];
  float bq[32], bb[32], kf[32];
#pragma unroll
  for (int jj = 0; jj < 32; jj++) {
    const int j = half * 32 + jj;
    const unsigned ro = (unsigned)((tau * 64 + (d == 0 ? j : 63 - j)) * UC);
    bq[jj] = bf2f(U[ro + qcol]);
    kf[jj] = bf2f(U[ro + fcol]);
  }
  float run = 0.f;
#pragma unroll
  for (int jj = 0; jj < 32; jj++) {
    const float f = lbv + (1.f - lbv) * sigmoidf_(kf[jj]);
    run += __logf(f);
    bb[jj] = run;
    kf[jj] = 1.f - f;
    bq[jj] = siluf_(bq[jj]);
  }
  __syncthreads();
  ex[half * 128 + kk] = run;
  __syncthreads();
  const float t0 = ex[kk], t1 = ex[128 + kk];
  const float mid = 0.5f * (t0 + t1);
  const float offs = half ? t0 : 0.f;
#pragma unroll
  for (int jj = 0; jj < 32; jj++) {
    const int j = half * 32 + jj;
    const int tok = tau * 64 + (d == 0 ? j : 63 - j);
    const float bcur = bb[jj] + offs;
    U[(unsigned)(tok * UC) + fcol] = f2bf(bq[jj] * __expf(bcur - mid));
    KSb[(unsigned)(tok * 1024)] = f2bf(kf[jj] * __expf(mid - bcur));
  }
  if (half == 0) p.EM[((size_t)(((bl * 2 + d) * 4 + hh) * NTILE + c)) * 128 + kk] = __expf(mid);
}

#define HS 136
#define HT 72
__device__ void hg_stream(const Params& p, int l, int item, unsigned char* smem) {
  const int vq = item & 3, hh = (item >> 2) & 3, d = (item >> 4) & 1, bl = item >> 5;
  bf16_t* Qs = (bf16_t*)smem;
  bf16_t* Ks = Qs + 64 * HS;
  bf16_t* Kst = Ks + 64 * HS;
  bf16_t* Vt = Kst + 128 * HT;
  bf16_t* Sb = Vt + 32 * HT;
  float* emS = (float*)(Sb + 32 * HS);
  const int tid = tid_opaque(), lane = tid & 63, wave = tid >> 6;
  const int r32 = lane & 31, h = lane >> 5;
  bf16_t* U = p.U + (size_t)bl * TT * UC;
  const bf16_t* KSb = p.KS + (size_t)bl * TT * 1024 + d * 512 + hh * 128;
  const float* EMb = p.EM + (size_t)(((bl * 2 + d) * 4 + hh) * NTILE) * 128;
  const int qscol = (d == 0 ? C_HFF : C_HFB) + hh * 128;
  const int vcol = C_HI + hh * 128 + vq * 32;
  const int ycol = (d == 0 ? Y_HF : Y_HB) + hh * 128 + vq * 32;
  const int j0 = tid >> 4, c8 = (tid & 15) * 8;
  const int vj = tid >> 2, vc8 = (tid & 3) * 8;
  f32x16 T0, T1;
#pragma unroll
  for (int r = 0; r < 16; r++) { T0[r] = 0.f; T1[r] = 0.f; }
  uint4 aQ0, aQ1, aQ2, aQ3, aK0, aK1, aK2, aK3, aV, bQ0, bQ1, bQ2, bQ3, bK0, bK1, bK2, bK3, bV;
  float aem = 0.f, bem = 0.f;
#define HG_TOKEN(tau, jj) ((tau)*64 + (d == 0 ? (jj) : 63 - (jj)))
#define HG_LD1(cc, i, RQ, RK)                                                   \
  {                                                                             \
    const int tok_ = HG_TOKEN(tile_of(cc, d), j0 + 16 * (i));                   \
    RQ = *(const uint4*)(U + (unsigned)(tok_ * UC) + qscol + c8);               \
    RK = *(const uint4*)(KSb + (unsigned)(tok_ * 1024) + c8);                   \
  }
#define HG_ISSUE(cc)                                                            \
  {                                                                             \
    HG_LD1(cc, 0, rQ0, rK0) HG_LD1(cc, 1, rQ1, rK1) HG_LD1(cc, 2, rQ2, rK2) HG_LD1(cc, 3, rQ3, rK3) \
    rV = *(const uint4*)(U + (unsigned)(HG_TOKEN(tile_of(cc, d), vj) * UC) + vcol + vc8); \
    if (tid < 128) rem = EMb[(cc)*128 + tid];                                   \
  }
  auto chunk = [&](const int c, uint4& rQ0, uint4& rQ1, uint4& rQ2, uint4& rQ3, uint4& rK0, uint4& rK1, uint4& rK2,
                   uint4& rK3, uint4& rV, float& rem) __attribute__((always_inline)) {
    const int tau = tile_of(c, d);
#define HG_CM1(i, RQ, RK)                                                   \
    {                                                                       \
      const int j = j0 + 16 * (i);                                          \
      *(uint4*)(Qs + j * HS + c8) = RQ;                                     \
      *(uint4*)(Ks + j * HS + c8) = RK;                                     \
      Kst[(c8 + 0) * HT + j] = (bf16_t)(RK.x & 0xffffu);                    \
      Kst[(c8 + 1) * HT + j] = (bf16_t)(RK.x >> 16);                        \
      Kst[(c8 + 2) * HT + j] = (bf16_t)(RK.y & 0xffffu);                    \
      Kst[(c8 + 3) * HT + j] = (bf16_t)(RK.y >> 16);                        \
      Kst[(c8 + 4) * HT + j] = (bf16_t)(RK.z & 0xffffu);                    \
      Kst[(c8 + 5) * HT + j] = (bf16_t)(RK.z >> 16);                        \
      Kst[(c8 + 6) * HT + j] = (bf16_t)(RK.w & 0xffffu);                    \
      Kst[(c8 + 7) * HT + j] = (bf16_t)(RK.w >> 16);                        \
    }
    HG_CM1(0, rQ0, rK0) HG_CM1(1, rQ1, rK1) HG_CM1(2, rQ2, rK2) HG_CM1(3, rQ3, rK3)
#undef HG_CM1
    {
      const unsigned wv[4] = {rV.x, rV.y, rV.z, rV.w};
#pragma unroll
      for (int q = 0; q < 4; q++) {
        Vt[(vc8 + 2 * q) * HT + vj] = (bf16_t)(wv[q] & 0xffffu);
        Vt[(vc8 + 2 * q + 1) * HT + vj] = (bf16_t)(wv[q] >> 16);
      }
    }
    if (tid < 128) emS[tid] = rem;
    __syncthreads();
    if (c + 2 < NTILE) HG_ISSUE(c + 2)
    f32x16 Y;
#pragma unroll
    for (int r = 0; r < 16; r++) Y[r] = 0.f;
    if (wave >= 2) {
#pragma unroll
      for (int kbi = 0; kbi < 2; kbi++) {
        const int kb = 2 * (wave - 2) + kbi;
#pragma unroll
        for (int g4 = 0; g4 < 4; g4++) {
          const int kk0 = kb * 32 + 8 * g4 + 4 * h;
          const float4 e4 = *(const float4*)(emS + kk0);
          float v0, v1, v2, v3;
          if (kbi == 0) { v0 = T0[4 * g4]; v1 = T0[4 * g4 + 1]; v2 = T0[4 * g4 + 2]; v3 = T0[4 * g4 + 3]; }
          else { v0 = T1[4 * g4]; v1 = T1[4 * g4 + 1]; v2 = T1[4 * g4 + 2]; v3 = T1[4 * g4 + 3]; }
          uint2 pk;
          pk.x = pack2bf(v0 * e4.x, v1 * e4.y);
          pk.y = pack2bf(v2 * e4.z, v3 * e4.w);
          *(uint2*)(Sb + r32 * HS + kk0) = pk;
        }
      }
    } else {
      const int ib = wave;
#pragma unroll 1
      for (int jb = 0; jb <= ib; jb++) {
        f32x16 G;
#pragma unroll
        for (int r = 0; r < 16; r++) G[r] = 0.f;
#pragma unroll
        for (int ks = 0; ks < 8; ks++) {
          bf16x8 a = *(const bf16x8*)(Ks + (jb * 32 + r32) * HS + ks * 16 + 8 * h);
          bf16x8 bb = *(const bf16x8*)(Qs + (ib * 32 + r32) * HS + ks * 16 + 8 * h);
          G = __builtin_amdgcn_mfma_f32_32x32x16_bf16(a, bb, G, 0, 0, 0);
        }
        if (jb == ib) {
#pragma unroll
          for (int r = 0; r < 16; r++) {
            const int jr = (r & 3) + 8 * (r >> 2) + 4 * h;
            G[r] = (jr <= r32) ? G[r] : 0.f;
          }
        }
#pragma unroll
        for (int s2 = 0; s2 < 2; s2++) {
          float t8[8];
#pragma unroll
          for (int q = 0; q < 8; q++) t8[q] = G[8 * s2 + q];
          bf16x8 a = pack_bf16x8(t8);
          const bf16_t* bp = Vt + r32 * HT + jb * 32 + 16 * s2 + 4 * h;
          uint2 lo = *(const uint2*)bp, hi = *(const uint2*)(bp + 8);
          uint4 t4 = make_uint4(lo.x, lo.y, hi.x, hi.y);
          bf16x8 bb = *(bf16x8*)&t4;
          Y = __builtin_amdgcn_mfma_f32_32x32x16_bf16(a, bb, Y, 0, 0, 0);
        }
      }
    }
    __syncthreads();
    if (wave < 2) {
      const int ib = wave;
#pragma unroll
      for (int ks = 0; ks < 8; ks++) {
        bf16x8 a = *(const bf16x8*)(Qs + (ib * 32 + r32) * HS + ks * 16 + 8 * h);
        bf16x8 bb = *(const bf16x8*)(Sb + r32 * HS + ks * 16 + 8 * h);
        Y = __builtin_amdgcn_mfma_f32_32x32x16_bf16(a, bb, Y, 0, 0, 0);
      }
#pragma unroll
      for (int r = 0; r < 16; r++) {
        const int i = ib * 32 + (r & 3) + 8 * (r >> 2) + 4 * h;
        U[(unsigned)(HG_TOKEN(tau, i) * UC) + ycol + r32] = f2bf(Y[r]);
      }
    } else {
#pragma unroll
      for (int kbi = 0; kbi < 2; kbi++) {
        const int kb = 2 * (wave - 2) + kbi;
        f32x16 acc;
#pragma unroll
        for (int r = 0; r < 16; r++) acc[r] = 0.f;
#pragma unroll
        for (int ks = 0; ks < 4; ks++) {
          bf16x8 a = *(const bf16x8*)(Kst + (kb * 32 + r32) * HT + ks * 16 + 8 * h);
          bf16x8 bb = *(const bf16x8*)(Vt + r32 * HT + ks * 16 + 8 * h);
          acc = __builtin_amdgcn_mfma_f32_32x32x16_bf16(a, bb, acc, 0, 0, 0);
        }
#pragma unroll
        for (int r = 0; r < 16; r++) {
          const float e = emS[kb * 32 + (r & 3) + 8 * (r >> 2) + 4 * h];
          if (kbi == 0) T0[r] = e * (e * T0[r] + acc[r]);
          else T1[r] = e * (e * T1[r] + acc[r]);
        }
      }
    }
    __syncthreads();
  };
  __syncthreads();
  {
    uint4 &rQ0 = aQ0, &rQ1 = aQ1, &rQ2 = aQ2, &rQ3 = aQ3, &rK0 = aK0, &rK1 = aK1, &rK2 = aK2, &rK3 = aK3, &rV = aV;
    float& rem = aem;
    HG_ISSUE(0)
  }
  {
    uint4 &rQ0 = bQ0, &rQ1 = bQ1, &rQ2 = bQ2, &rQ3 = bQ3, &rK0 = bK0, &rK1 = bK1, &rK2 = bK2, &rK3 = bK3, &rV = bV;
    float& rem = bem;
    HG_ISSUE(1)
  }
  for (int c = 0; c < NTILE; c += 2) {
    chunk(c, aQ0, aQ1, aQ2, aQ3, aK0, aK1, aK2, aK3, aV, aem);
    chunk(c + 1, bQ0, bQ1, bQ2, bQ3, bK0, bK1, bK2, bK3, bV, bem);
  }
#undef HG_TOKEN
#undef HG_ISSUE
#undef HG_LD1
}

__device__ void m2_prep(const Params& p, int l, int item, unsigned char* smem) {
  const int cb = item % 12, span = (item / 12) % 17, bl = item / 204;
  bf16_t* raw = (bf16_t*)smem;
  const int tid = tid_opaque();
  bf16_t* Ub = p.U + ((size_t)bl * TT + span * 256) * UC;
  bf16_t* Ux = Ub + C_MX + cb * 64;
  __syncthreads();
  {
    const int r0 = tid >> 3, c8 = (tid & 7) * 8;
    uint4 t0 = *(const uint4*)(Ux + (size_t)(r0)*UC + c8), t1 = *(const uint4*)(Ux + (size_t)(r0 + 32) * UC + c8),
          t2 = *(const uint4*)(Ux + (size_t)(r0 + 64) * UC + c8), t3 = *(const uint4*)(Ux + (size_t)(r0 + 96) * UC + c8),
          t4 = *(const uint4*)(Ux + (size_t)(r0 + 128) * UC + c8), t5 = *(const uint4*)(Ux + (size_t)(r0 + 160) * UC + c8),
          t6 = *(const uint4*)(Ux + (size_t)(r0 + 192) * UC + c8), t7 = *(const uint4*)(Ux + (size_t)(r0 + 224) * UC + c8);
    *(uint4*)(raw + (r0)*64 + c8) = t0;
    *(uint4*)(raw + (r0 + 32) * 64 + c8) = t1;
    *(uint4*)(raw + (r0 + 64) * 64 + c8) = t2;
    *(uint4*)(raw + (r0 + 96) * 64 + c8) = t3;
    *(uint4*)(raw + (r0 + 128) * 64 + c8) = t4;
    *(uint4*)(raw + (r0 + 160) * 64 + c8) = t5;
    *(uint4*)(raw + (r0 + 192) * 64 + c8) = t6;
    *(uint4*)(raw + (r0 + 224) * 64 + c8) = t7;
  }
  __syncthreads();
  {
    const int c = tid & 63, r0 = tid >> 6;
    const int col = cb * 64 + c;
    const float w0 = p.m2_conv_w[(l * 4 + 0) * 768 + col], w1 = p.m2_conv_w[(l * 4 + 1) * 768 + col],
                w2 = p.m2_conv_w[(l * 4 + 2) * 768 + col], w3 = p.m2_conv_w[(l * 4 + 3) * 768 + col];
    const float bias = p.m2_conv_b[l * 768 + col];
#pragma unroll 8
    for (int i = 0; i < 64; i++) {
      const int r = r0 + 4 * i;
      const int lo = span == 0 ? 0 : (r & ~63), hi = span == 0 ? 256 : (r & ~63) + 64;
      float sum = bias;
      if (r - 1 >= lo) sum += w0 * bf2f(raw[(r - 1) * 64 + c]);
      sum += w1 * bf2f(raw[r * 64 + c]);
      if (r + 1 < hi) sum += w2 * bf2f(raw[(r + 1) * 64 + c]);
      if (r + 2 < hi) sum += w3 * bf2f(raw[(r + 2) * 64 + c]);
      Ux[(size_t)r * UC + c] = f2bf(siluf_(sum));
    }
  }
  if (cb == 0) {
    for (int e = tid; e < 256 * 16; e += 256) {
      int r = e >> 4, j = e & 15;
      bf16_t* ptr = Ub + (size_t)r * UC + C_MDT + j;
      *ptr = f2bf(softplusf_(bf2f(*ptr) + p.m2_dt_bias[l * 16 + j]));
    }
  }
}

#define MS 72
__device__ void m2_stream(const Params& p, int l, int item, unsigned char* smem) {
  const int hd = item & 7, d = (item >> 3) & 1, bl = item >> 4;
  const int g2 = hd >> 2;
  bf16_t* Cm = (bf16_t*)smem;
  bf16_t* Bm = Cm + 64 * MS;
  bf16_t* Bmt = Bm + 64 * MS;
  bf16_t* Xt = Bmt + 64 * MS;
  bf16_t* Stt = Xt + 64 * MS;
  float* cumW = (float*)(Stt + 64 * MS);
  float* dtW = cumW + 64;
  float* wW = dtW + 64;
  const int tid = tid_opaque(), lane = tid & 63, wave = tid >> 6;
  bf16_t* U = p.U + (size_t)bl * TT * UC;
  const float aneg = -expf(p.m2_a_log[(l * 2 + d) * 8 + hd]);
  const float dsk = d == 0 ? p.m2_d[l * 8 + hd] : 0.f;
  const int ycol = (d == 0 ? Y_MF : Y_MB) + hd * 64;
  const int bcol = C_MX + 512 + g2 * 64, ccol = C_MX + 640 + g2 * 64, xcol = C_MX + hd * 64;
  const int dtcol = C_MDT + d * 8 + hd;
  const int r32 = lane & 31, h = lane >> 5;
  const int qa = wave >> 1, pb = wave & 1;
  const int j0 = tid >> 3, c8 = (tid & 7) * 8;
  f32x16 Sq;
#pragma unroll
  for (int r = 0; r < 16; r++) Sq[r] = 0.f;
  uint4 aB0, aB1, aC0, aC1, aX0, aX1, bB0, bB1, bC0, bC1, bX0, bX1;
  bf16_t adt, bdt;
#define M2_ROW(tau, jj) ((unsigned)(((tau)*64 + (d == 0 ? (jj) : 63 - (jj))) * UC))
#define M2_ISSUE(tau)                                            \
  {                                                              \
    const unsigned ra = M2_ROW(tau, j0), rb = M2_ROW(tau, j0 + 32); \
    rB0 = *(const uint4*)(U + ra + bcol + c8);                   \
    rB1 = *(const uint4*)(U + rb + bcol + c8);                   \
    rC0 = *(const uint4*)(U + ra + ccol + c8);                   \
    rC1 = *(const uint4*)(U + rb + ccol + c8);                   \
    rX0 = *(const uint4*)(U + ra + xcol + c8);                   \
    rX1 = *(const uint4*)(U + rb + xcol + c8);                   \
    rdt = U[M2_ROW(tau, lane) + dtcol];                          \
  }
  auto chunk = [&](const int c, uint4& rB0, uint4& rB1, uint4& rC0, uint4& rC1, uint4& rX0, uint4& rX1,
                   bf16_t& rdt) __attribute__((always_inline)) {
    const int tau = tile_of(c, d);
    {
      *(uint4*)(Bm + j0 * MS + c8) = rB0;
      *(uint4*)(Bm + (j0 + 32) * MS + c8) = rB1;
      *(uint4*)(Cm + j0 * MS + c8) = rC0;
      *(uint4*)(Cm + (j0 + 32) * MS + c8) = rC1;
      const unsigned wB0[4] = {rB0.x, rB0.y, rB0.z, rB0.w};
      const unsigned wB1[4] = {rB1.x, rB1.y, rB1.z, rB1.w};
      const unsigned wX0[4] = {rX0.x, rX0.y, rX0.z, rX0.w};
      const unsigned wX1[4] = {rX1.x, rX1.y, rX1.z, rX1.w};
#pragma unroll
      for (int q = 0; q < 4; q++) {
        Bmt[(c8 + 2 * q) * MS + j0] = (bf16_t)(wB0[q] & 0xffffu);
        Bmt[(c8 + 2 * q + 1) * MS + j0] = (bf16_t)(wB0[q] >> 16);
        Bmt[(c8 + 2 * q) * MS + j0 + 32] = (bf16_t)(wB1[q] & 0xffffu);
        Bmt[(c8 + 2 * q + 1) * MS + j0 + 32] = (bf16_t)(wB1[q] >> 16);
        Xt[(c8 + 2 * q) * MS + j0] = (bf16_t)(wX0[q] & 0xffffu);
        Xt[(c8 + 2 * q + 1) * MS + j0] = (bf16_t)(wX0[q] >> 16);
        Xt[(c8 + 2 * q) * MS + j0 + 32] = (bf16_t)(wX1[q] & 0xffffu);
        Xt[(c8 + 2 * q + 1) * MS + j0 + 32] = (bf16_t)(wX1[q] >> 16);
      }
#pragma unroll
      for (int g4 = 0; g4 < 4; g4++) {
        uint2 pk;
        pk.x = pack2bf(Sq[4 * g4], Sq[4 * g4 + 1]);
        pk.y = pack2bf(Sq[4 * g4 + 2], Sq[4 * g4 + 3]);
        *(uint2*)(Stt + (pb * 32 + r32) * MS + qa * 32 + 8 * g4 + 4 * h) = pk;
      }
      if (wave == 0) {
        const float dtv = bf2f(rdt);
        float x = dtv * aneg;
#pragma unroll
        for (int off = 1; off < 64; off <<= 1) {
          float y = __shfl_up(x, off);
          if (lane >= off) x += y;
        }
        const float ce = __shfl(x, 63);
        cumW[lane] = x;
        dtW[lane] = dtv;
        wW[lane] = __expf(ce - x) * dtv;
      }
    }
    __syncthreads();
    if (c + 2 < NTILE) M2_ISSUE(tile_of(c + 2, d))
    const float cend = cumW[63];
    {
      const int ib = qa;
      f32x16 Y;
#pragma unroll
      for (int r = 0; r < 16; r++) Y[r] = 0.f;
#pragma unroll
      for (int ks = 0; ks < 4; ks++) {
        bf16x8 a = *(const bf16x8*)(Cm + (ib * 32 + r32) * MS + ks * 16 + 8 * h);
        bf16x8 bb = *(const bf16x8*)(Stt + (pb * 32 + r32) * MS + ks * 16 + 8 * h);
        Y = __builtin_amdgcn_mfma_f32_32x32x16_bf16(a, bb, Y, 0, 0, 0);
      }
#pragma unroll
      for (int g4 = 0; g4 < 4; g4++) {
        const float4 ci = *(const float4*)(cumW + ib * 32 + 8 * g4 + 4 * h);
        Y[4 * g4] *= __expf(ci.x);
        Y[4 * g4 + 1] *= __expf(ci.y);
        Y[4 * g4 + 2] *= __expf(ci.z);
        Y[4 * g4 + 3] *= __expf(ci.w);
      }
      const float cum_i = cumW[ib * 32 + r32];
#pragma unroll 1
      for (int jb = 0; jb <= ib; jb++) {
        f32x16 G;
#pragma unroll
        for (int r = 0; r < 16; r++) G[r] = 0.f;
#pragma unroll
        for (int ks = 0; ks < 4; ks++) {
          bf16x8 a = *(const bf16x8*)(Bm + (jb * 32 + r32) * MS + ks * 16 + 8 * h);
          bf16x8 bb = *(const bf16x8*)(Cm + (ib * 32 + r32) * MS + ks * 16 + 8 * h);
          G = __builtin_amdgcn_mfma_f32_32x32x16_bf16(a, bb, G, 0, 0, 0);
        }
#pragma unroll
        for (int g4 = 0; g4 < 4; g4++) {
          const int jbase = jb * 32 + 8 * g4 + 4 * h;
          const float4 cj = *(const float4*)(cumW + jbase);
          const float4 dj = *(const float4*)(dtW + jbase);
          const float cjv[4] = {cj.x, cj.y, cj.z, cj.w};
          const float djv[4] = {dj.x, dj.y, dj.z, dj.w};
#pragma unroll
          for (int q = 0; q < 4; q++) {
            const int r = 4 * g4 + q;
            const float val = G[r] * __expf(fminf(cum_i - cjv[q], 0.f)) * djv[q];
            G[r] = (jbase + q <= ib * 32 + r32) ? val : 0.f;
          }
        }
#pragma unroll
        for (int s2 = 0; s2 < 2; s2++) {
          float t8[8];
#pragma unroll
          for (int q = 0; q < 8; q++) t8[q] = G[8 * s2 + q];
          bf16x8 a = pack_bf16x8(t8);
          const bf16_t* bp = Xt + (pb * 32 + r32) * MS + jb * 32 + 16 * s2 + 4 * h;
          uint2 lo = *(const uint2*)bp, hi = *(const uint2*)(bp + 8);
          uint4 t4 = make_uint4(lo.x, lo.y, hi.x, hi.y);
          bf16x8 bb = *(bf16x8*)&t4;
          Y = __builtin_amdgcn_mfma_f32_32x32x16_bf16(a, bb, Y, 0, 0, 0);
        }
      }
#pragma unroll
      for (int r = 0; r < 16; r++) {
        const int i = ib * 32 + (r & 3) + 8 * (r >> 2) + 4 * h;
        const float xv = bf2f(Xt[(pb * 32 + r32) * MS + i]);
        U[M2_ROW(tau, i) + ycol + pb * 32 + r32] = f2bf(Y[r] + dsk * xv);
      }
    }
    {
      const float dec = __expf(cend);
#pragma unroll
      for (int r = 0; r < 16; r++) Sq[r] *= dec;
#pragma unroll
      for (int ks = 0; ks < 4; ks++) {
        const float4 w0 = *(const float4*)(wW + ks * 16 + 8 * h);
        const float4 w1 = *(const float4*)(wW + ks * 16 + 8 * h + 4);
        bf16x8 a = *(const bf16x8*)(Bmt + (qa * 32 + r32) * MS + ks * 16 + 8 * h);
        uint4 raw = *(const uint4*)(Xt + (pb * 32 + r32) * MS + ks * 16 + 8 * h);
        float t8[8];
        unpack8(raw, t8);
        t8[0] *= w0.x; t8[1] *= w0.y; t8[2] *= w0.z; t8[3] *= w0.w;
        t8[4] *= w1.x; t8[5] *= w1.y; t8[6] *= w1.z; t8[7] *= w1.w;
        bf16x8 bb = pack_bf16x8(t8);
        Sq = __builtin_amdgcn_mfma_f32_32x32x16_bf16(a, bb, Sq, 0, 0, 0);
      }
    }
    __syncthreads();
  };
  __syncthreads();
  {
    uint4 &rB0 = aB0, &rB1 = aB1, &rC0 = aC0, &rC1 = aC1, &rX0 = aX0, &rX1 = aX1;
    bf16_t& rdt = adt;
    M2_ISSUE(tile_of(0, d))
  }
  {
    uint4 &rB0 = bB0, &rB1 = bB1, &rC0 = bC0, &rC1 = bC1, &rX0 = bX0, &rX1 = bX1;
    bf16_t& rdt = bdt;
    M2_ISSUE(tile_of(1, d))
  }
  for (int c = 0; c < NTILE; c += 2) {
    chunk(c, aB0, aB1, aC0, aC1, aX0, aX1, adt);
    chunk(c + 1, bB0, bB1, bC0, bC1, bX0, bX1, bdt);
  }
#undef M2_ROW
#undef M2_ISSUE
}

__device__ void s5_stream(const Params& p, int l, int item, unsigned char* smem) {
  const int g4 = item & 7, d = (item >> 3) & 1, bl = item >> 4;
  const int tid = tid_opaque(), lane = tid & 63, wave = tid >> 6;
  const int g = g4 * 4 + wave;
  bf16_t* buT = (bf16_t*)(smem + wave * 18944);
  unsigned* st = (unsigned*)(smem + wave * 18944 + 10240);
  bf16_t* U = p.U + (size_t)bl * TT * UC;
  const float* pbase = p.s5p + (size_t)(((l * 2 + d) * 32 + g) * 64) * 34;
  const float are = pbase[lane * 34], aim = pbase[lane * 34 + 1];
  const int kq = lane >> 4, c16 = lane & 15;
  bf16x8 bfB[8];
#pragma unroll
  for (int cb = 0; cb < 8; cb++) {
    const int kk = cb * 16 + c16;
    const float* pr = pbase + (kk >> 1) * 34 + ((kk & 1) ? 18 : 2);
#pragma unroll
    for (int j = 0; j < 8; j++) {
      float v = pr[(8 * kq + j) & 15];
      bfB[cb][j] = (short)f2bf(kq < 2 ? v : 0.f);
    }
  }
  bf16x8 cf[4];
  {
    const float* cre = p.s5_c_re + ((size_t)(l * 32 + g) * 16 + c16) * 64;
    const float* cim = p.s5_c_im + ((size_t)(l * 32 + g) * 16 + c16) * 64;
#pragma unroll
    for (int ks = 0; ks < 4; ks++) {
#pragma unroll
      for (int j = 0; j < 8; j++) {
        int kk = 8 * kq + 32 * ks + j;
        int n = kk >> 1;
        float val = (kk & 1) ? -cim[n] : cre[n];
        cf[ks][j] = (short)f2bf(val);
      }
    }
  }
  __syncthreads();
  float sre = 0.f, sim = 0.f;
  const int ucol = C_SU + g * 16 + (kq & 1) * 8;
  const int ycol = (d == 0 ? Y_SF : Y_SB) + g * 16;
#define S5_ROW(sb, jj) ((unsigned)((tile_of((sb) >> 1, d) * 64 + (d == 0 ? (((sb)&1) * 32 + (jj)) : 63 - (((sb)&1) * 32 + (jj)))) * UC))
  uint4 ru0 = *(const uint4*)(U + S5_ROW(0, c16) + ucol);
  uint4 ru1 = *(const uint4*)(U + S5_ROW(0, 16 + c16) + ucol);
  for (int sb = 0; sb < 2 * NTILE; sb++) {
    uint4 cur0 = ru0, cur1 = ru1;
    if (kq >= 2) { cur0 = make_uint4(0u, 0u, 0u, 0u); cur1 = cur0; }
    const bf16x8 af0 = *(bf16x8*)&cur0;
    const bf16x8 af1 = *(bf16x8*)&cur1;
    __builtin_amdgcn_wave_barrier();
#pragma unroll
    for (int cb = 0; cb < 8; cb++) {
      f32x4 a0 = {0.f, 0.f, 0.f, 0.f}, a1 = {0.f, 0.f, 0.f, 0.f};
      a0 = __builtin_amdgcn_mfma_f32_16x16x32_bf16(af0, bfB[cb], a0, 0, 0, 0);
      a1 = __builtin_amdgcn_mfma_f32_16x16x32_bf16(af1, bfB[cb], a1, 0, 0, 0);
      uint2 w0, w1;
      w0.x = pack2bf(a0[0], a0[1]); w0.y = pack2bf(a0[2], a0[3]);
      w1.x = pack2bf(a1[0], a1[1]); w1.y = pack2bf(a1[2], a1[3]);
      *(uint2*)(buT + (cb * 16 + c16) * 40 + 4 * kq) = w0;
      *(uint2*)(buT + (cb * 16 + c16) * 40 + 16 + 4 * kq) = w1;
    }
    if (sb + 1 < 2 * NTILE) {
      ru0 = *(const uint4*)(U + S5_ROW(sb + 1, c16) + ucol);
      ru1 = *(const uint4*)(U + S5_ROW(sb + 1, 16 + c16) + ucol);
    }
    __builtin_amdgcn_wave_barrier();
    {
      float bre[32], bim[32];
#pragma unroll
      for (int q = 0; q < 4; q++) {
        const uint4 r = *(const uint4*)(buT + (2 * lane) * 40 + 8 * q);
        const uint4 m = *(const uint4*)(buT + (2 * lane + 1) * 40 + 8 * q);
        const unsigned rw[4] = {r.x, r.y, r.z, r.w};
        const unsigned mw[4] = {m.x, m.y, m.z, m.w};
#pragma unroll
        for (int e = 0; e < 4; e++) {
          bre[8 * q + 2 * e] = __uint_as_float(rw[e] << 16);
          bre[8 * q + 2 * e + 1] = __uint_as_float(rw[e] & 0xffff0000u);
          bim[8 * q + 2 * e] = __uint_as_float(mw[e] << 16);
          bim[8 * q + 2 * e + 1] = __uint_as_float(mw[e] & 0xffff0000u);
        }
      }
#pragma unroll
      for (int jj = 0; jj < 32; jj++) {
        const float nr = are * sre - aim * sim + bre[jj];
        const float ni = are * sim + aim * sre + bim[jj];
        sre = nr;
        sim = ni;
        st[jj * 68 + lane] = pack2bf(sre, sim);
      }
    }
    __builtin_amdgcn_wave_barrier();
#pragma unroll
    for (int tb = 0; tb < 2; tb++) {
      f32x4 acc = {0.f, 0.f, 0.f, 0.f};
#pragma unroll
      for (int ks = 0; ks < 4; ks++) {
        bf16x8 a = *(const bf16x8*)((const unsigned char*)st + (tb * 16 + c16) * 272 + (8 * kq + 32 * ks) * 2);
        acc = __builtin_amdgcn_mfma_f32_16x16x32_bf16(a, cf[ks], acc, 0, 0, 0);
      }
#pragma unroll
      for (int i = 0; i < 4; i++) U[S5_ROW(sb, tb * 16 + 4 * kq + i) + ycol + c16] = f2bf(acc[i]);
    }
  }
#undef S5_ROW
}

__device__ void lru_prep(const Params& p, int l, int item, unsigned char* smem) {
  const int n = item & 7, tau = (item >> 3) % NTILE, bl = (item >> 3) / NTILE;
  bf16_t* Wt = (bf16_t*)smem;
  bf16_t* xc = Wt + 4 * 64 * 72;
  bf16_t* raw = xc + 64 * 72;
  bf16_t* U = p.U + (size_t)bl * TT * UC;
  const int tid = tid_opaque(), lane = tid & 63, wave = tid >> 6;
  const int d = wave >> 1, half = wave & 1;
  __syncthreads();
  {
    uint4 w8[8];
#pragma unroll
    for (int i = 0; i < 8; i++) {
      const int e = tid + 256 * i;
      const int dg = e >> 9, dout = (e >> 3) & 63, c8 = (e & 7) * 8;
      w8[i] = *(const uint4*)(p.Wlru + ((size_t)((l * 4 + dg) * 8 + n) * 64 + dout) * 64 + c8);
    }
    uint4 x3[3];
#pragma unroll
    for (int i = 0; i < 3; i++) {
      const int e = tid + 256 * i;
      const int rr = e >> 3, c8 = (e & 7) * 8;
      const int tt = rr - 1;
      const bool ok = (e < 67 * 8) && ((tau < 4) ? ((tau * 64 + tt) >= 0 && (tau * 64 + tt) < CTXL) : (tt >= 0 && tt < 64));
      x3[i] = make_uint4(0u, 0u, 0u, 0u);
      if (ok) x3[i] = *(const uint4*)(U + (size_t)(tau * 64 + tt) * UC + C_LX + n * 64 + c8);
    }
#pragma unroll
    for (int i = 0; i < 8; i++) {
      const int e = tid + 256 * i;
      const int dg = e >> 9, dout = (e >> 3) & 63, c8 = (e & 7) * 8;
      *(uint4*)(Wt + (dg * 64 + dout) * 72 + c8) = w8[i];
    }
#pragma unroll
    for (int i = 0; i < 3; i++) {
      const int e = tid + 256 * i;
      const int rr = e >> 3, c8 = (e & 7) * 8;
      if (e < 67 * 8) *(uint4*)(raw + rr * 64 + c8) = x3[i];
    }
  }
  __syncthreads();
  {
    const int cc = tid & 63, t0 = tid >> 6;
    const float* cw = p.lru_conv_w + (size_t)l * 4 * 512 + n * 64 + cc;
    const float w0 = cw[0], w1 = cw[512], w2 = cw[1024], w3 = cw[1536];
    const float bias = p.lru_conv_b[l * 512 + n * 64 + cc];
#pragma unroll 4
    for (int i = 0; i < 16; i++) {
      const int ti = t0 + 4 * i;
      float sum = bias + w0 * bf2f(raw[(ti)*64 + cc]) + w1 * bf2f(raw[(ti + 1) * 64 + cc]) +
                  w2 * bf2f(raw[(ti + 2) * 64 + cc]) + w3 * bf2f(raw[(ti + 3) * 64 + cc]);
      xc[ti * 72 + cc] = f2bf(sum);
    }
  }
  __syncthreads();
  const int dout = half * 32 + (lane & 31);
  const int ch = n * 64 + dout;
  const float gbr = p.lru_gate_b[(((l * 2 + d) * 2 + 0) * 8 + n) * 64 + dout];
  const float gbi = p.lru_gate_b[(((l * 2 + d) * 2 + 1) * 8 + n) * 64 + dout];
  const float spl = softplusf_(-p.lru_lam[(l * 2 + d) * 512 + ch]);
  const int r32 = lane & 31, kh = (lane >> 5) * 8;
  f32x16 acc[2][2];
#pragma unroll
  for (int i = 0; i < 2; i++)
#pragma unroll
    for (int j = 0; j < 2; j++)
#pragma unroll
      for (int r = 0; r < 16; r++) acc[i][j][r] = 0.f;
#pragma unroll
  for (int ks = 0; ks < 4; ks++) {
    bf16x8 a0 = *(const bf16x8*)(xc + (r32)*72 + ks * 16 + kh);
    bf16x8 a1 = *(const bf16x8*)(xc + (32 + r32) * 72 + ks * 16 + kh);
#pragma unroll
    for (int gt = 0; gt < 2; gt++) {
      bf16x8 b = *(const bf16x8*)(Wt + ((d * 2 + gt) * 64 + half * 32 + r32) * 72 + ks * 16 + kh);
      acc[0][gt] = __builtin_amdgcn_mfma_f32_32x32x16_bf16(a0, b, acc[0][gt], 0, 0, 0);
      acc[1][gt] = __builtin_amdgcn_mfma_f32_32x32x16_bf16(a1, b, acc[1][gt], 0, 0, 0);
    }
  }
#pragma unroll
  for (int tb = 0; tb < 2; tb++)
#pragma unroll
    for (int reg = 0; reg < 16; reg++) {
      int tok = tb * 32 + (reg & 3) + 8 * (reg >> 2) + 4 * (lane >> 5);
      float r = sigmoidf_(acc[tb][0][reg] + gbr);
      float ig = sigmoidf_(acc[tb][1][reg] + gbi);
      float la = -8.f * r * spl;
      float bc = sqrtf(fmaxf(1.f - __expf(2.f * la), 0.f));
      float xv = bf2f(xc[tok * 72 + dout]);
      unsigned ro = (unsigned)((tau * 64 + tok) * UC);
      U[ro + (d == 0 ? L_LAF : L_LAB) + ch] = f2bf(la);
      U[ro + (d == 0 ? Y_LF : Y_LB) + ch] = f2bf(bc * ig * xv);
    }
}

__device__ void lru_scan(const Params& p, int item, unsigned char* smem) {
  const int cgp = item & 15, d = (item >> 4) & 1, bl = item >> 5;
  const int tid = tid_opaque(), cl = tid & 31, seg = tid >> 5;
  const int ch = cgp * 32 + cl;
  float* sA = (float*)smem;
  float* sH = sA + 256;
  bf16_t* U = p.U + (size_t)bl * TT * UC;
  const int lacol = (d == 0 ? L_LAF : L_LAB) + ch;
  const int ycol = (d == 0 ? Y_LF : Y_LB) + ch;
#define LRU_ROW(s_) ((size_t)(d == 0 ? (s_) : ((s_) < 256 ? 255 - (s_) : 4607 - (s_))) * UC)
  float A = 1.f, hh = 0.f;
  for (int s0 = seg * 544; s0 < seg * 544 + 544; s0 += 32) {
    float la[32], bx[32];
#pragma unroll
    for (int i = 0; i < 32; i++) {
      const size_t ro = LRU_ROW(s0 + i);
      la[i] = bf2f(U[ro + lacol]);
      bx[i] = bf2f(U[ro + ycol]);
    }
#pragma unroll
    for (int i = 0; i < 32; i++) {
      const float a = __expf(la[i]);
      A *= a;
      hh = a * hh + bx[i];
    }
  }
  __syncthreads();
  sA[seg * 32 + cl] = A;
  sH[seg * 32 + cl] = hh;
  __syncthreads();
  float h0 = 0.f;
  for (int s2 = 0; s2 < seg; s2++) h0 = sA[s2 * 32 + cl] * h0 + sH[s2 * 32 + cl];
  hh = h0;
  for (int s0 = seg * 544; s0 < seg * 544 + 544; s0 += 32) {
    float la[32], bx[32];
#pragma unroll
    for (int i = 0; i < 32; i++) {
      const size_t ro = LRU_ROW(s0 + i);
      la[i] = bf2f(U[ro + lacol]);
      bx[i] = bf2f(U[ro + ycol]);
    }
#pragma unroll
    for (int i = 0; i < 32; i++) {
      hh = __expf(la[i]) * hh + bx[i];
      U[LRU_ROW(s0 + i) + ycol] = f2bf(hh);
    }
  }
#undef LRU_ROW
}

__device__ void finalize_row(const Params& p, int l, int r) {
  const int tid = tid_opaque();
  const int lane = tid & 63;
  bf16_t* row = p.U + (size_t)r * UC;
  const int c0 = lane * 8;
  const uint4 uHF = ld_nt_u4(row + Y_HF + c0), uHB = ld_nt_u4(row + Y_HB + c0), uHZ = ld_nt_u4(row + C_HZ + c0),
              uSF = ld_nt_u4(row + Y_SF + c0), uSB = ld_nt_u4(row + Y_SB + c0), uSU = ld_nt_u4(row + C_SU + c0),
              uMF = ld_nt_u4(row + Y_MF + c0), uMB = ld_nt_u4(row + Y_MB + c0), uMZ = ld_nt_u4(row + C_MZ + c0),
              uLF = ld_nt_u4(row + Y_LF + c0), uLB = ld_nt_u4(row + Y_LB + c0), uLZ = ld_nt_u4(row + C_LZ + c0);
  float a[8], b[8], z[8], o[8];
  unpack8(uHF, a); unpack8(uHB, b); unpack8(uHZ, z);
  float ss = 0.f;
#pragma unroll
  for (int i = 0; i < 8; i++) {
    a[i] += b[i];
    ss += a[i] * a[i];
  }
  ss += __shfl_xor(ss, 1);
  ss += __shfl_xor(ss, 2);
  ss += __shfl_xor(ss, 4);
  ss += __shfl_xor(ss, 8);
  float rstd = rsqrtf(ss * (1.f / 128.f) + EPS);
  {
    const float4 n0 = *(const float4*)(p.hg_norm + l * 512 + c0), n1 = *(const float4*)(p.hg_norm + l * 512 + c0 + 4);
    const float nw[8] = {n0.x, n0.y, n0.z, n0.w, n1.x, n1.y, n1.z, n1.w};
#pragma unroll
    for (int i = 0; i < 8; i++) o[i] = a[i] * rstd * nw[i] * siluf_(z[i]);
  }
  store8(row + Y_HF + c0, o);
  unpack8(uSF, a); unpack8(uSB, b); unpack8(uSU, z);
  {
    const float4 n0 = *(const float4*)(p.s5_d + l * 512 + c0), n1 = *(const float4*)(p.s5_d + l * 512 + c0 + 4);
    const float nw[8] = {n0.x, n0.y, n0.z, n0.w, n1.x, n1.y, n1.z, n1.w};
#pragma unroll
    for (int i = 0; i < 8; i++) o[i] = geluf_(a[i] + b[i] + nw[i] * z[i]);
  }
  store8(row + Y_SF + c0, o);
  unpack8(uMF, a); unpack8(uMB, b); unpack8(uMZ, z);
  ss = 0.f;
#pragma unroll
  for (int i = 0; i < 8; i++) {
    a[i] = (a[i] + b[i]) * siluf_(z[i]);
    ss += a[i] * a[i];
  }
#pragma unroll
  for (int m = 1; m < 64; m <<= 1) ss += __shfl_xor(ss, m);
  rstd = rsqrtf(ss * (1.f / 512.f) + EPS);
  {
    const float4 n0 = *(const float4*)(p.m2_norm + l * 512 + c0), n1 = *(const float4*)(p.m2_norm + l * 512 + c0 + 4);
    const float nw[8] = {n0.x, n0.y, n0.z, n0.w, n1.x, n1.y, n1.z, n1.w};
#pragma unroll
    for (int i = 0; i < 8; i++) o[i] = a[i] * rstd * nw[i];
  }
  store8(row + Y_MF + c0, o);
  unpack8(uLF, a); unpack8(uLB, b); unpack8(uLZ, z);
#pragma unroll
  for (int i = 0; i < 8; i++) o[i] = (a[i] + b[i]) * siluf_(z[i]);
  store8(row + Y_LF + c0, o);
}

__device__ void phase_prep(const Params& p, int l, unsigned char* smem) {
  const int total = 2176 + 2176 + 816;
  for (int it = blockIdx.x; it < total; it += gridDim.x) {
    if (it < 2176) lru_prep(p, l, it, smem);
    else if (it < 4352) hg_prep(p, l, it - 2176, smem);
    else m2_prep(p, l, it - 4352, smem);
  }
}

__device__ void phase_scan(const Params& p, int l, unsigned char* smem, int mask, unsigned* zctr) {
  const int total = 64 + 64 + 128 + 128;
  for (int it = blockIdx.x; it < total; it += gridDim.x) {
    if (it < 64) {
      const int xc = it & 7, slot = it >> 3;
      const int gidx = xc * 2 + (slot >> 2);
      const int item = ((gidx >> 1) << 3) | ((gidx & 1) * 4 + (slot & 3));
      if (mask & 1) m2_stream(p, l, item, smem);
    }
    else if (it < 128) { if (mask & 2) s5_stream(p, l, it - 64, smem); }
    else if (it < 256) {
      const int b2 = it - 128, xc = b2 & 7, slot = b2 >> 3;
      const int item = (xc * 4 + (slot >> 2)) * 4 + (slot & 3);
      if (mask & 4) hg_stream(p, l, item, smem);
    }
    else { if (mask & 8) lru_scan(p, it - 256, smem); }
  }
  if (zctr) zgate_tiles(p, l, zctr, smem);
}

__device__ void phase_fin1(const Params& p, int l) {
  const int tid = tid_opaque();
  if (l == 0) {
    const int total = RG / 4;
    for (int it = blockIdx.x; it < total; it += gridDim.x) finalize_row(p, l, it * 4 + (tid >> 6));
  } else {
    const int total = GB * SEQ / 4;
    for (int it = blockIdx.x; it < total; it += gridDim.x) {
      const int q = it * 4 + (tid >> 6);
      finalize_row(p, l, (q >> 12) * TT + CTXL + (q & 4095));
    }
  }
}

__device__ void phase_fin2(const Params& p, int l, unsigned char* smem) {
  const int tid = tid_opaque();
  const int ntm = RG / 128;
  const int n_glu = (l == 0 ? ntm : 128) * 4;
  const int total = n_glu;
  const bf16_t* Wt = p.W + (size_t)l * W_LAYER + W_GLU_OFF;
  for (int it = blockIdx.x; it < total; it += gridDim.x) {
    if (it < n_glu) {
      int tm, tn;
      if (l == 0) { tm = it % ntm; tn = it / ntm; }
      else { const int tml = it & 127; tn = it >> 7; tm = (tml >> 5) * 34 + 2 + (tml & 31); }
      f32x16 acc[2][2];
      acc_zero<2, 2>(acc);
      gemm_main<2, 2>(p.U + (size_t)tm * 128 * UC + Y_SF, UC, Wt + (size_t)tn * 128 * 512, 512, 512, acc, smem);
#pragma unroll
      for (int i = 0; i < 2; i++)
#pragma unroll
        for (int jn = 0; jn < 2; jn++)
#pragma unroll
          for (int reg = 0; reg < 16; reg++) {
            int row = tm * 128 + ACC_ROW(i, reg), col = tn * 128 + ACC_COL(2, jn);
            bf16_t* rp = p.U + (size_t)row * UC;
            float gv = bf2f(rp[Y_SF + col]);
            float zv = bf2f(rp[C_SZ + col]);
            float val = gv * sigmoidf_(acc[i][jn][reg] + p.s5_b_glu[l * 512 + col]) * siluf_(zv);
            rp[Y_SB + col] = f2bf(val);
          }
    }
  }
}

template <int TN>
__device__ __forceinline__ void merge_tile(const Params& p, int l, int tm, int tn, unsigned char* smem) {
  const int tid = tid_opaque();
  constexpr int BN = 64 * TN;
  const bf16_t* Wl = p.W + (size_t)l * W_LAYER;
  f32x16 macc[2][TN];
  acc_zero<2, TN>(macc);
#pragma unroll 1
  for (int k = 0; k < 4; k++) {
    f32x16 acc[2][TN];
    acc_zero<2, TN>(acc);
    gemm_main<2, TN, false>(p.H + ((size_t)tm * 128) * 1024, 1024, Wl + W_G_OFF + ((size_t)k * 1024 + tn * BN) * 1024,
                               1024, 1024, acc, smem);
    unsigned sg[2][TN][4];
#pragma unroll
    for (int jn = 0; jn < TN; jn++) {
      const float bg = p.b_gate[(l * 4 + k) * 1024 + tn * BN + ACC_COL(TN, jn)];
#pragma unroll
      for (int i = 0; i < 2; i++)
#pragma unroll
        for (int r4 = 0; r4 < 4; r4++) {
          unsigned w = 0;
#pragma unroll
          for (int q = 0; q < 4; q++) {
            const float sv = sigmoidf_(acc[i][jn][4 * r4 + q] + bg);
            w |= ((unsigned)(sv * 255.f + 0.5f)) << (8 * q);
          }
          sg[i][jn][r4] = w;
        }
    }
    acc_zero<2, TN>(acc);
    const int yc = k == 0 ? Y_HF : (k == 1 ? Y_SB : (k == 2 ? Y_LF : Y_MF));
    gemm_main<2, TN, false>(p.U + (size_t)tm * 128 * UC + yc, UC, Wl + W_B_OFF + ((size_t)k * 1024 + tn * BN) * 512, 512,
                               512, acc, smem);
#pragma unroll
    for (int i = 0; i < 2; i++)
#pragma unroll
      for (int jn = 0; jn < TN; jn++)
#pragma unroll
        for (int r4 = 0; r4 < 4; r4++) {
          const unsigned w = sg[i][jn][r4];
#pragma unroll
          for (int q = 0; q < 4; q++)
            macc[i][jn][4 * r4 + q] += (float)((w >> (8 * q)) & 0xffu) * (1.f / 255.f) * acc[i][jn][4 * r4 + q];
        }
  }
#pragma unroll
  for (int i = 0; i < 2; i++)
#pragma unroll
    for (int jn = 0; jn < TN; jn++)
#pragma unroll
      for (int reg = 0; reg < 16; reg++) {
        int row = tm * 128 + ACC_ROW(i, reg), col = tn * BN + ACC_COL(TN, jn);
        p.U[(size_t)row * UC + col] = f2bf(macc[i][jn][reg]);
      }
}

__device__ void phase_merge(const Params& p, int l, int g, unsigned char* smem) {
  const int n_lat = 128 * 8;
  const int total = n_lat + (l == 0 ? 128 : 0);
  for (int it = blockIdx.x; it < total; it += gridDim.x) {
    if (it < n_lat) {
      const int tml = it % 128, tn = it / 128;
      const int tm = (tml >> 5) * 34 + 2 + (tml & 31);
      merge_tile<2>(p, l, tm, tn, smem);
    } else {
      const int i2 = it - n_lat;
      const int tmc = i2 & 7, tn = i2 >> 3;
      const int tm = (tmc >> 1) * 34 + (tmc & 1);
      merge_tile<1>(p, l, tm, tn, smem);
    }
  }
  (void)g;
}

__device__ void phase_out(const Params& p, int l, int g, unsigned char* smem) {
  const int tid = tid_opaque();
  const int ntm = RG / 128, ntn = 8;
  const bf16_t* Wt = p.W + (size_t)l * W_LAYER + W_O_OFF;
  for (int it = blockIdx.x; it < ntm * ntn; it += gridDim.x) {
    int tm = it % ntm, tn = it / ntm;
    if (l == 1 && (tm % 34) < 2) continue;
    f32x16 acc[2][2];
    acc_zero<2, 2>(acc);
    gemm_main<2, 2>(p.U + (size_t)tm * 128 * UC, UC, Wt + (size_t)tn * 128 * 1024, 1024, 1024, acc, smem);
#pragma unroll
    for (int i = 0; i < 2; i++)
#pragma unroll
      for (int jn = 0; jn < 2; jn++)
#pragma unroll
        for (int reg = 0; reg < 16; reg++) {
          int R = g * RG + tm * 128 + ACC_ROW(i, reg), col = tn * 128 + ACC_COL(2, jn);
          int b = R / TT, t = R % TT;
          float v = acc[i][jn][reg];
          if (t < CTXL) {
            if (l == 0) {
              size_t idx = (size_t)(b * CTXL + t) * 1024 + col;
              p.ctx1[idx] = p.ctx[idx] + p.mod[(size_t)(l * 9 + 8) * 3072 + 2048 + col] * v;
            }
          } else {
            size_t idx = (size_t)(b * SEQ + t - CTXL) * 1024 + col;
            float gt = p.mod[(size_t)(l * 9 + b) * 3072 + 2048 + col];
            float base = (l == 0) ? p.x[idx] : p.out[idx];
            p.out[idx] = base + gt * v;
          }
        }
  }
}

__device__ void phase_final(const Params& p) {
  const int tid = tid_opaque();
  const int lane = tid & 63, wave = tid >> 6;
  for (int it = blockIdx.x; it < NB * SEQ / 4; it += gridDim.x) {
    int r = it * 4 + wave;
    float* src = p.out + (size_t)r * 1024;
    float4 v[4];
    float ss = 0.f;
#pragma unroll
    for (int i = 0; i < 4; i++) {
      v[i] = ld_nt_f4(src + i * 256 + lane * 4);
      ss += v[i].x * v[i].x + v[i].y * v[i].y + v[i].z * v[i].z + v[i].w * v[i].w;
    }
#pragma unroll
    for (int m = 1; m < 64; m <<= 1) ss += __shfl_xor(ss, m);
    float rstd = rsqrtf(ss * (1.f / 1024.f) + EPS);
#pragma unroll
    for (int i = 0; i < 4; i++) {
      int c0 = i * 256 + lane * 4;
      float4 w = *(const float4*)(p.final_norm + c0);
      float4 o;
      o.x = v[i].x * rstd * w.x;
      o.y = v[i].y * rstd * w.y;
      o.z = v[i].z * rstd * w.z;
      o.w = v[i].w * rstd * w.w;
      st_nt_f4(src + c0, o);
    }
  }
}

#define XB_TMO      128
#define XB_XCNT(j)  (256  + 64 * (j))
#define XB_XSUB(j)  (1280 + 64 * (j))
#define XB_XGEN(j)  (2304 + 64 * (j))
#define XB_TOP      3328
#define XB_TOPGEN   3392
#define XCD_BAR_WORDS 3456
#define XB_SPIN_CAP (1u << 18)
#define LAS __attribute__((address_space(3)))

__device__ __forceinline__ unsigned xb_ld(unsigned* p)              { return __hip_atomic_load(p, __ATOMIC_RELAXED, __HIP_MEMORY_SCOPE_AGENT); }
__device__ __forceinline__ unsigned xb_add(unsigned* p, unsigned v) { return __hip_atomic_fetch_add(p, v, __ATOMIC_RELAXED, __HIP_MEMORY_SCOPE_AGENT); }
__device__ __forceinline__ unsigned xb_xcc_id() { return (unsigned)__builtin_amdgcn_s_getreg((3 << 11) | 20) & 0xFu; }
#define XB_SPIN(cond, bar) do { unsigned _sp = 0; while (cond) { __builtin_amdgcn_s_sleep(1); \
    if ((++_sp & 255u) == 0u) { if (xb_ld(&(bar)[XB_TMO])) break; if (_sp > XB_SPIN_CAP) { atomicAdd(&(bar)[XB_TMO], 1u); break; } } } } while (0)

struct XcdBarrier {
    unsigned* bar; unsigned x;
    volatile LAS unsigned* st;
};

__device__ __forceinline__ XcdBarrier xcd_barrier_post(unsigned* bar, volatile LAS unsigned* st) {
    XcdBarrier b; b.bar = bar; b.x = xb_xcc_id(); b.st = st;
    if (threadIdx.x == 0) (void)xb_add(&bar[XB_XCNT(b.x)], 1u);
    return b;
}
__device__ __forceinline__ void xcd_barrier_complete(unsigned* bar, unsigned x, unsigned& nloc, unsigned& nx) {
    const unsigned G = gridDim.x * gridDim.y * gridDim.z;
    unsigned sum, cnt, mine, sp = 0u;
    for (;;) {
        sum = 0u; cnt = 0u; mine = 0u;
#pragma unroll
        for (unsigned j = 0; j < 16; ++j) { const unsigned c = xb_ld(&bar[XB_XCNT(j)]); sum += c; cnt += (c > 0u) ? 1u : 0u; mine = (j == x) ? c : mine; }
        if (sum == G) break;
        __builtin_amdgcn_s_sleep(1);
        if ((++sp & 255u) == 0u) { if (xb_ld(&bar[XB_TMO])) break; if (sp > XB_SPIN_CAP) { atomicAdd(&bar[XB_TMO], 1u); break; } }
    }
    nloc = mine > 0u ? mine : 1u; nx = cnt > 0u ? cnt : 1u;
}

__device__ __forceinline__ void xcd_barrier(const XcdBarrier& b) {
    asm volatile("s_waitcnt vmcnt(0)" ::: "memory");
    __syncthreads();
    if (threadIdx.x == 0) {
        unsigned* bar = b.bar;
        __builtin_amdgcn_s_waitcnt(0);
        unsigned nloc = b.st[0], nx = b.st[1];
        if (nloc == 0u) { xcd_barrier_complete(bar, b.x, nloc, nx); b.st[0] = nloc; b.st[1] = nx; }
        const unsigned old = xb_add(&bar[XB_XSUB(b.x)], 1u);
        const unsigned gen = old / nloc;
        if (old + 1u == (gen + 1u) * nloc) {
            __builtin_amdgcn_fence(__ATOMIC_RELEASE, "agent");
            asm volatile("s_waitcnt vmcnt(0)" ::: "memory");
            const unsigned og = xb_add(&bar[XB_TOP], 1u);
            const unsigned tg = og / nx;
            if (og + 1u == (tg + 1u) * nx) xb_add(&bar[XB_TOPGEN], 1u);
            else XB_SPIN(xb_ld(&bar[XB_TOPGEN]) == tg, bar);
            __builtin_amdgcn_fence(__ATOMIC_ACQUIRE, "agent");
            xb_add(&bar[XB_XGEN(b.x)], 1u);
            asm volatile("s_waitcnt vmcnt(0)" ::: "memory");
        } else {
            XB_SPIN(xb_ld(&bar[XB_XGEN(b.x)]) == gen, bar);
            __builtin_amdgcn_fence(__ATOMIC_ACQUIRE, "agent");
            asm volatile("s_waitcnt vmcnt(0)" ::: "memory");
        }
    }
    __syncthreads();
}


#ifndef PH
#define PH 0xff
#endif
#define REP_INPROJ 1
#define REP_SCAN 0
#define REP_MERGE 1
__global__ void __launch_bounds__(256, 2) mega_kernel(Params p) {
  __shared__ __attribute__((aligned(16))) unsigned char smem[SMEM_BYTES];
  __shared__ uint4 xb_words;
  cg::grid_group grid = cg::this_grid();
  if (threadIdx.x == 0) xb_words = make_uint4(0u, 0u, 0u, 0u);
  __syncthreads();
  XcdBarrier xb = xcd_barrier_post(p.bar, (volatile LAS unsigned*)&xb_words);
#pragma unroll 1
  for (int step = 0; step < 31; step++) {
    int l = 0, g = 0, ph;
    if (step == 0) ph = 0;
    else if (step == 1) ph = 1;
    else if (step == 30) ph = 9;
    else {
      int s2 = step - 2;
      int lg = s2 / 7;
      l = lg >> 1;
      g = lg & 1;
      ph = 2 + (s2 % 7);
    }
    switch (ph) {
      case 0: phase0(p, smem); break;
      case 1: phase_norm(p, 0, 0); break;
      case 2: for (int rr = 0; rr < REP_INPROJ; rr++) phase_inproj(p, l, g, smem); break;
      case 3: phase_prep(p, l, smem); break;
      case 4: phase_scan(p, l, smem, 15, p.bar + XCD_BAR_WORDS + 64 * (l * 2 + g)); break;
      case 5: phase_fin1(p, l); break;
      case 6: phase_fin2(p, l, smem); break;
      case 7: for (int rr = 0; rr < REP_MERGE; rr++) phase_merge(p, l, g, smem); break;
      case 8:
        phase_out(p, l, g, smem);
        if (!(l == 1 && g == 1)) phase_norm(p, g == 1 ? l + 1 : l, g ^ 1);
        break;
      default: phase_final(p); break;
    }
    if (step == 0) grid.sync();
    else if (step != 30) xcd_barrier(xb);
  }
}

extern "C" void kernel_launch(void* const* d_in, const int* in_sizes, int n_in, void* d_out, int out_size, void* d_ws,
                              size_t ws_size, hipStream_t stream) {
  static int grid_blocks = 0;
  if (!grid_blocks) {
    int dev = 0, cus = 0, per_cu = 0;
    hipGetDevice(&dev);
    hipDeviceGetAttribute(&cus, hipDeviceAttributeMultiprocessorCount, dev);
    hipOccupancyMaxActiveBlocksPerMultiprocessor(&per_cu, mega_kernel, 256, 0);
    if (per_cu > 2) per_cu = 2;
    if (per_cu < 1) per_cu = 1;
    grid_blocks = cus * per_cu;
  }
  Params p{};
  const float** pp = (const float**)&p;
  for (int i = 0; i < 36; i++) pp[i] = (const float*)d_in[i];
  p.out = (float*)d_out;
  unsigned char* ws = (unsigned char*)d_ws;
  size_t off = 0;
  p.U = (bf16_t*)(ws + off);
  off += (size_t)RG * UC * 2;
  p.H = (bf16_t*)(ws + off);
  off += (size_t)RG * 1024 * 2;
  p.KS = (bf16_t*)(ws + off);
  off += (size_t)RG * 1024 * 2;
  p.EM = (float*)(ws + off);
  off += (size_t)GB * 2 * 4 * NTILE * 128 * 4;
  p.W = (bf16_t*)(ws + off);
  off += (size_t)2 * W_LAYER * 2;
  p.ctx1 = (float*)(ws + off);
  off += (size_t)NB * CTXL * 1024 * 4;
  p.mod = (float*)(ws + off);
  off += (size_t)2 * 9 * 3072 * 4;
  p.lb = (float*)(ws + off);
  off += (size_t)2 * 1024 * 4;
  p.s5p = (float*)(ws + off);
  off += (size_t)8192 * 34 * 4;
  p.Wlru = (bf16_t*)(ws + off);
  off += (size_t)64 * 4096 * 2;
  p.bar = (unsigned*)(ws + off);
  off += (size_t)(XCD_BAR_WORDS + 256) * 4;
  hipMemsetAsync(p.bar, 0, (size_t)(XCD_BAR_WORDS + 256) * 4, stream);
  if (off > ws_size) fprintf(stderr, "workspace too small: need %zu have %zu\n", off, ws_size);
  void* args[] = {&p};
  hipError_t e = hipLaunchCooperativeKernel((void*)mega_kernel, dim3(grid_blocks), dim3(256), args, 0, stream);
  if (e != hipSuccess) fprintf(stderr, "cooperative launch failed: %s (grid %d)\n", hipGetErrorString(e), grid_blocks);
}
```

```cpp
#include <hip/hip_runtime.h>
#include <hip/hip_bf16.h>
#include <hip/hip_cooperative_groups.h>
#include <cstdio>
namespace cg = cooperative_groups;

typedef unsigned short bf16_t;
typedef __attribute__((ext_vector_type(8))) short bf16x8;
typedef __attribute__((ext_vector_type(4))) float f32x4;
typedef __attribute__((ext_vector_type(16))) float f32x16;

#define DM 1024
#define NB 8
#define SEQ 4096
#define CTXL 256
#define TT 4352
#define NTOK (NB * TT)
#define GB 4
#define NGRP 2
#define RG (GB * TT)
#define NTILE 68
#define UC 11136
#define NIN 6016
#define EPS 1e-6f

#define C_HQ 0
#define C_HI 512
#define C_HFF 1024
#define C_HFB 1536
#define C_HZ 2048
#define C_SU 2560
#define C_SZ 3072
#define C_LX 3584
#define C_LZ 4096
#define C_MX 4608
#define C_MZ 5376
#define C_MDT 5888
#define Y_HF 6016
#define Y_HB 6528
#define Y_SF 7040
#define Y_SB 7552
#define Y_LF 8064
#define Y_LB 8576
#define Y_MF 9088
#define Y_MB 9600
#define L_LAF 10112
#define L_LAB 10624

#define W_IN_OFF 0
#define W_G_OFF (NIN * 1024)
#define W_B_OFF (W_G_OFF + 4096 * 1024)
#define W_O_OFF (W_B_OFF + 4 * 1024 * 512)
#define W_GLU_OFF (W_O_OFF + 1024 * 1024)
#define W_LAYER (W_GLU_OFF + 512 * 512)

#define SMEM_BYTES 75776

struct Params {
  const float *x, *c, *ctx, *c_ctx, *norm_w, *w_mod, *b_mod, *w_in, *hg_lb_logits, *hg_norm,
      *s5_a_re, *s5_a_im, *s5_log_step, *s5_b_re, *s5_b_im, *s5_c_re, *s5_c_im, *s5_d, *s5_w_glu, *s5_b_glu,
      *lru_conv_w, *lru_conv_b, *lru_gate_w, *lru_gate_b, *lru_lam,
      *m2_conv_w, *m2_conv_b, *m2_dt_bias, *m2_a_log, *m2_d, *m2_norm,
      *w_branch, *w_gate, *b_gate, *w_out, *final_norm;
  float* out;
  bf16_t* U;
  bf16_t* H;
  bf16_t* W;
  float* ctx1;
  float* mod;
  float* lb;
  float* s5p;
  bf16_t* Wlru;
  unsigned* bar;
  bf16_t* KS;
  float* EM;
};

__device__ __forceinline__ bf16_t f2bf(float f) {
  unsigned u = __float_as_uint(f);
  u += 0x7fffu + ((u >> 16) & 1u);
  return (bf16_t)(u >> 16);
}
typedef __attribute__((ext_vector_type(2))) float f32x2_t;
typedef __attribute__((ext_vector_type(2))) __bf16 bf16x2_t;
__device__ __forceinline__ unsigned pack2bf(float a, float b) {
  f32x2_t v = {a, b};
  bf16x2_t r = __builtin_convertvector(v, bf16x2_t);
  return *(unsigned*)&r;
}
__device__ __forceinline__ float bf2f(bf16_t h) { return __uint_as_float(((unsigned)h) << 16); }
__device__ __forceinline__ float sigmoidf_(float x) { return 1.f / (1.f + __expf(-x)); }
__device__ __forceinline__ float siluf_(float x) { return x / (1.f + __expf(-x)); }
__device__ __forceinline__ float softplusf_(float x) { return x > 20.f ? x : log1pf(__expf(x)); }
__device__ __forceinline__ float geluf_(float y) {
  return 0.5f * y * (1.f + tanhf(0.7978845608028654f * (y + 0.044715f * y * y * y)));
}
__device__ __forceinline__ int tid_opaque() {
  int t = threadIdx.x;
  asm volatile("" : "+v"(t));
  return t;
}
__device__ __forceinline__ int tile_of(int c, int d) { return d == 0 ? c : (c < 4 ? 3 - c : 71 - c); }

__device__ __forceinline__ void load8(const bf16_t* p, float (&v)[8]) {
  uint4 r = *(const uint4*)p;
  unsigned w[4] = {r.x, r.y, r.z, r.w};
#pragma unroll
  for (int i = 0; i < 4; i++) {
    v[2 * i] = __uint_as_float(w[i] << 16);
    v[2 * i + 1] = __uint_as_float(w[i] & 0xffff0000u);
  }
}
__device__ __forceinline__ void store8(bf16_t* p, const float (&v)[8]) {
  uint4 r;
  r.x = (unsigned)f2bf(v[0]) | ((unsigned)f2bf(v[1]) << 16);
  r.y = (unsigned)f2bf(v[2]) | ((unsigned)f2bf(v[3]) << 16);
  r.z = (unsigned)f2bf(v[4]) | ((unsigned)f2bf(v[5]) << 16);
  r.w = (unsigned)f2bf(v[6]) | ((unsigned)f2bf(v[7]) << 16);
  *(uint4*)p = r;
}

#define GSTR 40
template <int TMW, int TN, bool PL = true>
__device__ __forceinline__ void gemm_main(const bf16_t* __restrict__ A, int lda, const bf16_t* __restrict__ Bt,
                                          int ldb, int K, f32x16 (&acc)[TMW][TN], unsigned char* smem) {
  constexpr int BM = 64 * TMW, BN = 64 * TN;
  bf16_t* As = (bf16_t*)smem;
  bf16_t* Bs = As + 2 * BM * GSTR;
  const int tid = tid_opaque(), lane = tid & 63, wave = tid >> 6;
  const int wm = wave >> 1, wn = wave & 1;
  const int lr = tid >> 2, lc = (tid & 3) * 8;
  const unsigned aoff = (unsigned)(lr * lda + lc), boff = (unsigned)(lr * ldb + lc);
  const bf16_t* A2 = A + (size_t)64 * lda;
  const bf16_t* A3 = A + (size_t)128 * lda;
  const bf16_t* A4 = A + (size_t)192 * lda;
  const bf16_t* B2 = Bt + (size_t)64 * ldb;
  uint4 pa0, pa1, pa2, pa3, pb0, pb1, qa0, qa1, qa2, qa3, qb0, qb1;
  const int r32 = lane & 31, kh = (lane >> 5) * 8;
  const int KT = K / 32;
#define G_LOAD(R, k0)                                    \
  R##a0 = *(const uint4*)(A + (aoff + (k0)));            \
  R##a1 = *(const uint4*)(A2 + (aoff + (k0)));           \
  if (TMW == 4) {                                        \
    R##a2 = *(const uint4*)(A3 + (aoff + (k0)));         \
    R##a3 = *(const uint4*)(A4 + (aoff + (k0)));         \
  }                                                      \
  R##b0 = *(const uint4*)(Bt + (boff + (k0)));           \
  if (TN == 2) R##b1 = *(const uint4*)(B2 + (boff + (k0)));
#define G_STORE(R, buf)                                                   \
  *(uint4*)(As + ((buf)*BM + lr) * GSTR + lc) = R##a0;                    \
  *(uint4*)(As + ((buf)*BM + lr + 64) * GSTR + lc) = R##a1;               \
  if (TMW == 4) {                                                         \
    *(uint4*)(As + ((buf)*BM + lr + 128) * GSTR + lc) = R##a2;            \
    *(uint4*)(As + ((buf)*BM + lr + 192) * GSTR + lc) = R##a3;            \
  }                                                                       \
  *(uint4*)(Bs + ((buf)*BN + lr) * GSTR + lc) = R##b0;                    \
  if (TN == 2) *(uint4*)(Bs + ((buf)*BN + lr + 64) * GSTR + lc) = R##b1;
#define G_COMPUTE(buf)                                                                                        \
  if (PL) {                                                                                                   \
    bf16x8 bfr[2][TN], afr[2][TMW];                                                                           \
    _Pragma("unroll") for (int ks = 0; ks < 2; ks++) {                                                        \
      _Pragma("unroll") for (int jn = 0; jn < TN; jn++)                                                       \
        bfr[ks][jn] = *(const bf16x8*)(Bs + ((buf)*BN + wn * 32 * TN + jn * 32 + r32) * GSTR + ks * 16 + kh); \
      _Pragma("unroll") for (int im = 0; im < TMW; im++)                                                      \
        afr[ks][im] = *(const bf16x8*)(As + ((buf)*BM + wm * 32 * TMW + im * 32 + r32) * GSTR + ks * 16 + kh); \
    }                                                                                                         \
    _Pragma("unroll") for (int ks = 0; ks < 2; ks++)                                                          \
      _Pragma("unroll") for (int im = 0; im < TMW; im++)                                                      \
        _Pragma("unroll") for (int jn = 0; jn < TN; jn++)                                                     \
          acc[im][jn] = __builtin_amdgcn_mfma_f32_32x32x16_bf16(afr[ks][im], bfr[ks][jn], acc[im][jn], 0, 0, 0); \
  } else {                                                                                                    \
    _Pragma("unroll") for (int ks = 0; ks < 2; ks++) {                                                        \
      bf16x8 bfr[TN];                                                                                         \
      _Pragma("unroll") for (int jn = 0; jn < TN; jn++)                                                       \
        bfr[jn] = *(const bf16x8*)(Bs + ((buf)*BN + wn * 32 * TN + jn * 32 + r32) * GSTR + ks * 16 + kh);     \
      _Pragma("unroll") for (int im = 0; im < TMW; im++) {                                                    \
        bf16x8 af = *(const bf16x8*)(As + ((buf)*BM + wm * 32 * TMW + im * 32 + r32) * GSTR + ks * 16 + kh);  \
        _Pragma("unroll") for (int jn = 0; jn < TN; jn++)                                                     \
          acc[im][jn] = __builtin_amdgcn_mfma_f32_32x32x16_bf16(af, bfr[jn], acc[im][jn], 0, 0, 0);           \
      }                                                                                                       \
    }                                                                                                         \
  }
  __syncthreads();
  G_LOAD(p, 0)
  G_LOAD(q, 32)
  G_STORE(p, 0)
  __syncthreads();
  for (int kt = 0; kt < KT; kt += 2) {
    if (kt + 2 < KT) { G_LOAD(p, (kt + 2) * 32) }
    G_COMPUTE(0)
    G_STORE(q, 1)
    __syncthreads();
    if (kt + 3 < KT) { G_LOAD(q, (kt + 3) * 32) }
    G_COMPUTE(1)
    if (kt + 2 < KT) { G_STORE(p, 0) }
    __syncthreads();
  }
#undef G_LOAD
#undef G_STORE
#undef G_COMPUTE
}

template <int TMW, int TN>
__device__ __forceinline__ void acc_zero(f32x16 (&acc)[TMW][TN]) {
#pragma unroll
  for (int i = 0; i < TMW; i++)
#pragma unroll
    for (int j = 0; j < TN; j++)
#pragma unroll
      for (int r = 0; r < 16; r++) acc[i][j][r] = 0.f;
}

#define ACC_ROWM(TMW, i, reg) ((tid >> 7) * 32 * (TMW) + (i)*32 + ((reg)&3) + 8 * ((reg) >> 2) + 4 * ((tid & 63) >> 5))
#define ACC_ROW(i, reg) ACC_ROWM(2, i, reg)
#define ACC_COL(TN, jn) (((tid >> 6) & 1) * 32 * (TN) + (jn)*32 + (tid & 31))

__device__ __forceinline__ int win_srccol(int n) {
  if (n < 5376) return n;
  if (n < 5888) return n + 16;
  if (n < 5904) return n - 512;
  return -1;
}

__device__ void transpose_item(const float* __restrict__ src, int src_ld, bf16_t* __restrict__ dst, int dst_ld, int k0,
                               int n0, int mode, float* tile) {
  const int tid = tid_opaque();
  __syncthreads();
  for (int e = tid; e < 4096; e += 256) {
    int i = e >> 6, j = e & 63;
    int n = n0 + j;
    int sc = mode ? win_srccol(n) : n;
    tile[i * 65 + j] = sc >= 0 ? src[(size_t)(k0 + i) * src_ld + sc] : 0.f;
  }
  __syncthreads();
  for (int e = tid; e < 4096; e += 256) {
    int j = e >> 6, i = e & 63;
    dst[(size_t)(n0 + j) * dst_ld + k0 + i] = f2bf(tile[i * 65 + j]);
  }
}

__device__ void phase0(const Params& p, unsigned char* smem) {
  float* fs = (float*)smem;
  const int tid = tid_opaque();
  const int NT_L = 3360;
  const int n_tr = 2 * NT_L;
  const int n_mod = 384, n_lb = 4, n_s5 = 32, n_lw = 64;
  const int total = n_tr + n_mod + n_lb + n_s5 + n_lw;
  for (int it = blockIdx.x; it < total; it += gridDim.x) {
    if (it < n_tr) {
      int l = it / NT_L, idx = it % NT_L;
      bf16_t* Wl = p.W + (size_t)l * W_LAYER;
      if (idx < 1504) {
        int kt = idx % 16, nt = idx / 16;
        transpose_item(p.w_in + (size_t)l * 1024 * 5904, 5904, Wl + W_IN_OFF, 1024, kt * 64, nt * 64, 1, fs);
      } else if ((idx -= 1504) < 1024) {
        int kb = idx / 256, rem = idx % 256, kt = rem % 16, nt = rem / 16;
        transpose_item(p.w_gate + (size_t)(l * 4 + kb) * 1024 * 1024, 1024, Wl + W_G_OFF + (size_t)kb * 1024 * 1024,
                       1024, kt * 64, nt * 64, 0, fs);
      } else if ((idx -= 1024) < 512) {
        int kb = idx / 128, rem = idx % 128, kt = rem % 8, nt = rem / 8;
        transpose_item(p.w_branch + (size_t)(l * 4 + kb) * 512 * 1024, 1024, Wl + W_B_OFF + (size_t)kb * 1024 * 512,
                       512, kt * 64, nt * 64, 0, fs);
      } else if ((idx -= 512) < 256) {
        int kt = idx % 16, nt = idx / 16;
        transpose_item(p.w_out + (size_t)l * 1024 * 1024, 1024, Wl + W_O_OFF, 1024, kt * 64, nt * 64, 0, fs);
      } else {
        idx -= 256;
        int kt = idx % 8, nt = idx / 8;
        transpose_item(p.s5_w_glu + (size_t)l * 512 * 512, 512, Wl + W_GLU_OFF, 512, kt * 64, nt * 64, 0, fs);
      }
    } else if (it < n_tr + n_mod) {
      int m = it - n_tr;
      int l = m / 192, cb = m % 192;
      float* sc = fs;
      float* red = fs + 9 * 1024;
      __syncthreads();
      for (int e = tid; e < 9 * 1024; e += 256) {
        int r = e >> 10, k = e & 1023;
        float v = r < 8 ? p.c[r * 1024 + k] : p.c_ctx[k];
        sc[e] = siluf_(v);
      }
      __syncthreads();
      int cl = tid & 15, kq = tid >> 4;
      int col = cb * 16 + cl;
      float a[9];
#pragma unroll
      for (int r = 0; r < 9; r++) a[r] = 0.f;
      const float* wp = p.w_mod + (size_t)l * 1024 * 3072 + col;
#pragma unroll 8
      for (int k = kq * 64; k < kq * 64 + 64; k++) {
        float w = wp[(size_t)k * 3072];
#pragma unroll
        for (int r = 0; r < 9; r++) a[r] += sc[r * 1024 + k] * w;
      }
#pragma unroll
      for (int r = 0; r < 9; r++) red[(kq * 9 + r) * 16 + cl] = a[r];
      __syncthreads();
      if (tid < 144) {
        int r = tid >> 4, c2 = tid & 15;
        float sacc = 0.f;
#pragma unroll
        for (int q = 0; q < 16; q++) sacc += red[(q * 9 + r) * 16 + c2];
        int cc = cb * 16 + c2;
        p.mod[(size_t)(l * 9 + r) * 3072 + cc] = sacc + p.b_mod[l * 3072 + cc];
      }
    } else if (it < n_tr + n_mod + n_lb) {
      int q = (it - n_tr - n_mod) * 256 + tid;
      float x0 = p.hg_lb_logits[q], x1 = p.hg_lb_logits[1024 + q], x2 = p.hg_lb_logits[2048 + q];
      float mx = fmaxf(x0, fmaxf(x1, x2));
      float e0 = expf(x0 - mx), e1 = expf(x1 - mx), e2 = expf(x2 - mx);
      float s = e0 + e1 + e2;
      p.lb[q] = e0 / s;
      p.lb[1024 + q] = (e0 + e1) / s;
    } else if (it >= n_tr + n_mod + n_lb + n_s5) {
      int idx = it - (n_tr + n_mod + n_lb + n_s5);
      transpose_item(p.lru_gate_w + (size_t)idx * 4096, 64, p.Wlru + (size_t)idx * 4096, 64, 0, 0, 0, fs);
    } else {
      int q = (it - n_tr - n_mod - n_lb) * 256 + tid;
      int n = q & 63, g = (q >> 6) & 31, d = (q >> 11) & 1, l = q >> 12;
      int ai = ((l * 2 + d) * 32 + g) * 64 + n;
      float are = p.s5_a_re[ai], aim = p.s5_a_im[ai];
      float step = expf(p.s5_log_step[(l * 2 + d) * 32 + g]);
      float mag = expf(are * step);
      float sn, cs;
      sincosf(aim * step, &sn, &cs);
      float abr = mag * cs, abi = mag * sn;
      float nr = abr - 1.f, ni = abi;
      float den = are * are + aim * aim;
      float cr = (nr * are + ni * aim) / den;
      float ci = (ni * are - nr * aim) / den;
      float* o = p.s5p + (size_t)q * 34;
      o[0] = abr;
      o[1] = abi;
      const float* bre = p.s5_b_re + ((size_t)(l * 32 + g) * 64 + n) * 16;
      const float* bim = p.s5_b_im + ((size_t)(l * 32 + g) * 64 + n) * 16;
      for (int pp = 0; pp < 16; pp++) {
        float br = bre[pp], bi = bim[pp];
        o[2 + pp] = cr * br - ci * bi;
        o[18 + pp] = cr * bi + ci * br;
      }
    }
  }
}

__device__ void phase_norm(const Params& p, int l, int g) {
  const int tid = tid_opaque();
  const int lane = tid & 63, wave = tid >> 6;
  const float* nw = p.norm_w + l * 1024;
  for (int it = blockIdx.x; it < RG / 4; it += gridDim.x) {
    int rl = it * 4 + wave;
    int r = g * RG + rl;
    int b = r / TT, t = r % TT;
    const float* src;
    const float* md;
    if (t < CTXL) {
      src = (l == 0 ? p.ctx : p.ctx1) + (size_t)(b * CTXL + t) * 1024;
      md = p.mod + (size_t)(l * 9 + 8) * 3072;
    } else {
      src = (l == 0 ? p.x : p.out) + (size_t)(b * SEQ + t - CTXL) * 1024;
      md = p.mod + (size_t)(l * 9 + b) * 3072;
    }
    float4 v[4];
    float ss = 0.f;
#pragma unroll
    for (int i = 0; i < 4; i++) {
      v[i] = *(const float4*)(src + i * 256 + lane * 4);
      ss += v[i].x * v[i].x + v[i].y * v[i].y + v[i].z * v[i].z + v[i].w * v[i].w;
    }
#pragma unroll
    for (int m = 1; m < 64; m <<= 1) ss += __shfl_xor(ss, m);
    float rstd = rsqrtf(ss * (1.f / 1024.f) + EPS);
    bf16_t* dst = p.H + (size_t)rl * 1024;
#pragma unroll
    for (int i = 0; i < 4; i++) {
      int c0 = i * 256 + lane * 4;
      float4 w = *(const float4*)(nw + c0);
      float4 sh = *(const float4*)(md + c0);
      float4 sc = *(const float4*)(md + 1024 + c0);
      float o0 = v[i].x * rstd * w.x * (1.f + sc.x) + sh.x;
      float o1 = v[i].y * rstd * w.y * (1.f + sc.y) + sh.y;
      float o2 = v[i].z * rstd * w.z * (1.f + sc.z) + sh.z;
      float o3 = v[i].w * rstd * w.w * (1.f + sc.w) + sh.w;
      uint2 pk;
      pk.x = (unsigned)f2bf(o0) | ((unsigned)f2bf(o1) << 16);
      pk.y = (unsigned)f2bf(o2) | ((unsigned)f2bf(o3) << 16);
      *(uint2*)(dst + c0) = pk;
    }
  }
}

template <int TMW>
__device__ __forceinline__ void inproj_tile(const Params& p, int l, int tm, int ct, unsigned char* smem) {
  const int tid = tid_opaque();
  const bf16_t* Wt = p.W + (size_t)l * W_LAYER + W_IN_OFF;
  f32x16 acc[TMW][2];
  acc_zero<TMW, 2>(acc);
  gemm_main<TMW, 2>(p.H + (size_t)tm * (64 * TMW) * 1024, 1024, Wt + (size_t)ct * 128 * 1024, 1024, 1024, acc, smem);
#pragma unroll
  for (int i = 0; i < TMW; i++)
#pragma unroll
    for (int jn = 0; jn < 2; jn++)
#pragma unroll
      for (int reg = 0; reg < 16; reg++) {
        int row = tm * (64 * TMW) + ACC_ROWM(TMW, i, reg), col = ct * 128 + ACC_COL(2, jn);
        p.U[(unsigned)(row * UC + col)] = f2bf(acc[i][jn][reg]);
      }
}

__device__ void phase_inproj(const Params& p, int l, int g, unsigned char* smem) {
  const int ntm = RG / 128;
  for (int it = blockIdx.x; it < 31 * ntm; it += gridDim.x) {
    const int tm = it % ntm, ci = it / ntm;
    const int ct = ci < 16 ? ci : (ci < 20 ? ci + 4 : (ci < 24 ? ci + 8 : (ci < 30 ? ci + 12 : 46)));
    inproj_tile<2>(p, l, tm, ct, smem);
  }
  (void)g;
}

__device__ void zgate_tiles(const Params& p, int l, unsigned* ctr, unsigned char* smem) {
  __shared__ int zt_next;
  const int ntm = RG / 256;
  for (;;) {
    __syncthreads();
    if (threadIdx.x == 0) zt_next = (int)atomicAdd(ctr, 1u);
    __syncthreads();
    const int t = zt_next;
    if (t >= 16 * ntm) break;
    const int tm = t % ntm, zi = t / ntm;
    const int mix = zi >> 2;
    const int ct = (mix == 0 ? 16 : (mix == 1 ? 24 : (mix == 2 ? 32 : 42))) + (zi & 3);
    inproj_tile<4>(p, l, tm, ct, smem);
  }
}

template <int N>
__device__ __forceinline__ void rs_step(const float (&in)[2 * N], float (&out)[N], int bit, bool up) {
#pragma unroll
  for (int i = 0; i < N; i++) {
    float send = up ? in[i] : in[i + N];
    float keep = up ? in[i + N] : in[i];
    out[i] = keep + __shfl_xor(send, bit);
  }
}

__device__ __forceinline__ void unpack8(const uint4& r, float (&v)[8]) {
  v[0] = __uint_as_float(r.x << 16); v[1] = __uint_as_float(r.x & 0xffff0000u);
  v[2] = __uint_as_float(r.y << 16); v[3] = __uint_as_float(r.y & 0xffff0000u);
  v[4] = __uint_as_float(r.z << 16); v[5] = __uint_as_float(r.z & 0xffff0000u);
  v[6] = __uint_as_float(r.w << 16); v[7] = __uint_as_float(r.w & 0xffff0000u);
}

__device__ __forceinline__ bf16x8 pack_bf16x8(const float (&v)[8]) {
  uint4 t = make_uint4(pack2bf(v[0], v[1]), pack2bf(v[2], v[3]), pack2bf(v[4], v[5]), pack2bf(v[6], v[7]));
  return *(bf16x8*)&t;
}

__device__ void hg_prep(const Params& p, int l, int item, unsigned char* smem) {
  const int c = item % NTILE;
  const int rr = item / NTILE;
  const int hh = rr & 3, d = (rr >> 2) & 1, bl = rr >> 3;
  const int tid = tid_opaque();
  const int kk = tid & 127, half = tid >> 7;
  float* ex = (float*)smem;
  const int tau = tile_of(c, d);
  bf16_t* U = p.U + (size_t)bl * TT * UC;
  bf16_t* KSb = p.KS + (size_t)bl * TT * 1024 + d * 512 + hh * 128 + kk;
  const int qcol = C_HQ + hh * 128 + kk, fcol = (d == 0 ? C_HFF : C_HFB) + hh * 128 + kk;
  const float lbv = p.lb[(l * 2 + d) * 512 + hh * 128 + kk];
  float bq[32], bb[32], kf[32];
#pragma unroll
  for (int jj = 0; jj < 32; jj++) {
    const int j = half * 32 + jj;
    const unsigned ro = (unsigned)((tau * 64 + (d == 0 ? j : 63 - j)) * UC);
    bq[jj] = bf2f(U[ro + qcol]);
    kf[jj] = bf2f(U[ro + fcol]);
  }
  float run = 0.f;
#pragma unroll
  for (int jj = 0; jj < 32; jj++) {
    const float f = lbv + (1.f - lbv) * sigmoidf_(kf[jj]);
    run += __logf(f);
    bb[jj] = run;
    kf[jj] = 1.f - f;
    bq[jj] = siluf_(bq[jj]);
  }
  __syncthreads();
  ex[half * 128 + kk] = run;
  __syncthreads();
  const float t0 = ex[kk], t1 = ex[128 + kk];
  const float mid = 0.5f * (t0 + t1);
  const float offs = half ? t0 : 0.f;
#pragma unroll
  for (int jj = 0; jj < 32; jj++) {
    const int j = half * 32 + jj;
    const int tok = tau * 64 + (d == 0 ? j : 63 - j);
    const float bcur = bb[jj] + offs;
    U[(unsigned)(tok * UC) + fcol] = f2bf(bq[jj] * __expf(bcur - mid));
    KSb[(unsigned)(tok * 1024)] = f2bf(kf[jj] * __expf(mid - bcur));
  }
  if (half == 0) p.EM[((size_t)(((bl * 2 + d) * 4 + hh) * NTILE + c)) * 128 + kk] = __expf(mid);
}

#define HS 136
#define HT 72
__device__ void hg_stream(const Params& p, int l, int item, unsigned char* smem) {
  const int vq = item & 3, hh = (item >> 2) & 3, d = (item >> 4) & 1, bl = item >> 5;
  bf16_t* Qs = (bf16_t*)smem;
  bf16_t* Ks = Qs + 64 * HS;
  bf16_t* Kst = Ks + 64 * HS;
  bf16_t* Vt = Kst + 128 * HT;
  bf16_t* Sb = Vt + 32 * HT;
  float* emS = (float*)(Sb + 32 * HS);
  const int tid = tid_opaque(), lane = tid & 63, wave = tid >> 6;
  const int r32 = lane & 31, h = lane >> 5;
  bf16_t* U = p.U + (size_t)bl * TT * UC;
  const bf16_t* KSb = p.KS + (size_t)bl * TT * 1024 + d * 512 + hh * 128;
  const float* EMb = p.EM + (size_t)(((bl * 2 + d) * 4 + hh) * NTILE) * 128;
  const int qscol = (d == 0 ? C_HFF : C_HFB) + hh * 128;
  const int vcol = C_HI + hh * 128 + vq * 32;
  const int ycol = (d == 0 ? Y_HF : Y_HB) + hh * 128 + vq * 32;
  const int j0 = tid >> 4, c8 = (tid & 15) * 8;
  const int vj = tid >> 2, vc8 = (tid & 3) * 8;
  f32x16 T0, T1;
#pragma unroll
  for (int r = 0; r < 16; r++) { T0[r] = 0.f; T1[r] = 0.f; }
  uint4 aQ0, aQ1, aQ2, aQ3, aK0, aK1, aK2, aK3, aV, bQ0, bQ1, bQ2, bQ3, bK0, bK1, bK2, bK3, bV;
  float aem = 0.f, bem = 0.f;
#define HG_TOKEN(tau, jj) ((tau)*64 + (d == 0 ? (jj) : 63 - (jj)))
#define HG_LD1(cc, i, RQ, RK)                                                   \
  {                                                                             \
    const int tok_ = HG_TOKEN(tile_of(cc, d), j0 + 16 * (i));                   \
    RQ = *(const uint4*)(U + (unsigned)(tok_ * UC) + qscol + c8);               \
    RK = *(const uint4*)(KSb + (unsigned)(tok_ * 1024) + c8);                   \
  }
#define HG_ISSUE(cc)                                                            \
  {                                                                             \
    HG_LD1(cc, 0, rQ0, rK0) HG_LD1(cc, 1, rQ1, rK1) HG_LD1(cc, 2, rQ2, rK2) HG_LD1(cc, 3, rQ3, rK3) \
    rV = *(const uint4*)(U + (unsigned)(HG_TOKEN(tile_of(cc, d), vj) * UC) + vcol + vc8); \
    if (tid < 128) rem = EMb[(cc)*128 + tid];                                   \
  }
  auto chunk = [&](const int c, uint4& rQ0, uint4& rQ1, uint4& rQ2, uint4& rQ3, uint4& rK0, uint4& rK1, uint4& rK2,
                   uint4& rK3, uint4& rV, float& rem) __attribute__((always_inline)) {
    const int tau = tile_of(c, d);
#define HG_CM1(i, RQ, RK)                                                   \
    {                                                                       \
      const int j = j0 + 16 * (i);                                          \
      *(uint4*)(Qs + j * HS + c8) = RQ;                                     \
      *(uint4*)(Ks + j * HS + c8) = RK;                                     \
      Kst[(c8 + 0) * HT + j] = (bf16_t)(RK.x & 0xffffu);                    \
      Kst[(c8 + 1) * HT + j] = (bf16_t)(RK.x >> 16);                        \
      Kst[(c8 + 2) * HT + j] = (bf16_t)(RK.y & 0xffffu);                    \
      Kst[(c8 + 3) * HT + j] = (bf16_t)(RK.y >> 16);                        \
      Kst[(c8 + 4) * HT + j] = (bf16_t)(RK.z & 0xffffu);                    \
      Kst[(c8 + 5) * HT + j] = (bf16_t)(RK.z >> 16);                        \
      Kst[(c8 + 6) * HT + j] = (bf16_t)(RK.w & 0xffffu);                    \
      Kst[(c8 + 7) * HT + j] = (bf16_t)(RK.w >> 16);                        \
    }
    HG_CM1(0, rQ0, rK0) HG_CM1(1, rQ1, rK1) HG_CM1(2, rQ2, rK2) HG_CM1(3, rQ3, rK3)
#undef HG_CM1
    {
      const unsigned wv[4] = {rV.x, rV.y, rV.z, rV.w};
#pragma unroll
      for (int q = 0; q < 4; q++) {
        Vt[(vc8 + 2 * q) * HT + vj] = (bf16_t)(wv[q] & 0xffffu);
        Vt[(vc8 + 2 * q + 1) * HT + vj] = (bf16_t)(wv[q] >> 16);
      }
    }
    if (tid < 128) emS[tid] = rem;
    __syncthreads();
    if (c + 2 < NTILE) HG_ISSUE(c + 2)
    f32x16 Y;
#pragma unroll
    for (int r = 0; r < 16; r++) Y[r] = 0.f;
    if (wave >= 2) {
#pragma unroll
      for (int kbi = 0; kbi < 2; kbi++) {
        const int kb = 2 * (wave - 2) + kbi;
#pragma unroll
        for (int g4 = 0; g4 < 4; g4++) {
          const int kk0 = kb * 32 + 8 * g4 + 4 * h;
          const float4 e4 = *(const float4*)(emS + kk0);
          float v0, v1, v2, v3;
          if (kbi == 0) { v0 = T0[4 * g4]; v1 = T0[4 * g4 + 1]; v2 = T0[4 * g4 + 2]; v3 = T0[4 * g4 + 3]; }
          else { v0 = T1[4 * g4]; v1 = T1[4 * g4 + 1]; v2 = T1[4 * g4 + 2]; v3 = T1[4 * g4 + 3]; }
          uint2 pk;
          pk.x = pack2bf(v0 * e4.x, v1 * e4.y);
          pk.y = pack2bf(v2 * e4.z, v3 * e4.w);
          *(uint2*)(Sb + r32 * HS + kk0) = pk;
        }
      }
    } else {
      const int ib = wave;
#pragma unroll 1
      for (int jb = 0; jb <= ib; jb++) {
        f32x16 G;
#pragma unroll
        for (int r = 0; r < 16; r++) G[r] = 0.f;
#pragma unroll
        for (int ks = 0; ks < 8; ks++) {
          bf16x8 a = *(const bf16x8*)(Ks + (jb * 32 + r32) * HS + ks * 16 + 8 * h);
          bf16x8 bb = *(const bf16x8*)(Qs + (ib * 32 + r32) * HS + ks * 16 + 8 * h);
          G = __builtin_amdgcn_mfma_f32_32x32x16_bf16(a, bb, G, 0, 0, 0);
        }
        if (jb == ib) {
#pragma unroll
          for (int r = 0; r < 16; r++) {
            const int jr = (r & 3) + 8 * (r >> 2) + 4 * h;
            G[r] = (jr <= r32) ? G[r] : 0.f;
          }
        }
#pragma unroll
        for (int s2 = 0; s2 < 2; s2++) {
          float t8[8];
#pragma unroll
          for (int q = 0; q < 8; q++) t8[q] = G[8 * s2 + q];
          bf16x8 a = pack_bf16x8(t8);
          const bf16_t* bp = Vt + r32 * HT + jb * 32 + 16 * s2 + 4 * h;
          uint2 lo = *(const uint2*)bp, hi = *(const uint2*)(bp + 8);
          uint4 t4 = make_uint4(lo.x, lo.y, hi.x, hi.y);
          bf16x8 bb = *(bf16x8*)&t4;
          Y = __builtin_amdgcn_mfma_f32_32x32x16_bf16(a, bb, Y, 0, 0, 0);
        }
      }
    }
    __syncthreads();
    if (wave < 2) {
      const int ib = wave;
#pragma unroll
      for (int ks = 0; ks < 8; ks++) {
        bf16x8 a = *(const bf16x8*)(Qs + (ib * 32 + r32) * HS + ks * 16 + 8 * h);
        bf16x8 bb = *(const bf16x8*)(Sb + r32 * HS + ks * 16 + 8 * h);
        Y = __builtin_amdgcn_mfma_f32_32x32x16_bf16(a, bb, Y, 0, 0, 0);
      }
#pragma unroll
      for (int r = 0; r < 16; r++) {
        const int i = ib * 32 + (r & 3) + 8 * (r >> 2) + 4 * h;
        U[(unsigned)(HG_TOKEN(tau, i) * UC) + ycol + r32] = f2bf(Y[r]);
      }
    } else {
#pragma unroll
      for (int kbi = 0; kbi < 2; kbi++) {
        const int kb = 2 * (wave - 2) + kbi;
        f32x16 acc;
#pragma unroll
        for (int r = 0; r < 16; r++) acc[r] = 0.f;
#pragma unroll
        for (int ks = 0; ks < 4; ks++) {
          bf16x8 a = *(const bf16x8*)(Kst + (kb * 32 + r32) * HT + ks * 16 + 8 * h);
          bf16x8 bb = *(const bf16x8*)(Vt + r32 * HT + ks * 16 + 8 * h);
          acc = __builtin_amdgcn_mfma_f32_32x32x16_bf16(a, bb, acc, 0, 0, 0);
        }
#pragma unroll
        for (int r = 0; r < 16; r++) {
          const float e = emS[kb * 32 + (r & 3) + 8 * (r >> 2) + 4 * h];
          if (kbi == 0) T0[r] = e * (e * T0[r] + acc[r]);
          else T1[r] = e * (e * T1[r] + acc[r]);
        }
      }
    }
    __syncthreads();
  };
  __syncthreads();
  {
    uint4 &rQ0 = aQ0, &rQ1 = aQ1, &rQ2 = aQ2, &rQ3 = aQ3, &rK0 = aK0, &rK1 = aK1, &rK2 = aK2, &rK3 = aK3, &rV = aV;
    float& rem = aem;
    HG_ISSUE(0)
  }
  {
    uint4 &rQ0 = bQ0, &rQ1 = bQ1, &rQ2 = bQ2, &rQ3 = bQ3, &rK0 = bK0, &rK1 = bK1, &rK2 = bK2, &rK3 = bK3, &rV = bV;
    float& rem = bem;
    HG_ISSUE(1)
  }
  for (int c = 0; c < NTILE; c += 2) {
    chunk(c, aQ0, aQ1, aQ2, aQ3, aK0, aK1, aK2, aK3, aV, aem);
    chunk(c + 1, bQ0, bQ1, bQ2, bQ3, bK0, bK1, bK2, bK3, bV, bem);
  }
#undef HG_TOKEN
#undef HG_ISSUE
#undef HG_LD1
}

__device__ void m2_prep(const Params& p, int l, int item, unsigned char* smem) {
  const int cb = item % 12, span = (item / 12) % 17, bl = item / 204;
  bf16_t* raw = (bf16_t*)smem;
  const int tid = tid_opaque();
  bf16_t* Ub = p.U + ((size_t)bl * TT + span * 256) * UC;
  bf16_t* Ux = Ub + C_MX + cb * 64;
  __syncthreads();
  {
    const int r0 = tid >> 3, c8 = (tid & 7) * 8;
    uint4 t0 = *(const uint4*)(Ux + (size_t)(r0)*UC + c8), t1 = *(const uint4*)(Ux + (size_t)(r0 + 32) * UC + c8),
          t2 = *(const uint4*)(Ux + (size_t)(r0 + 64) * UC + c8), t3 = *(const uint4*)(Ux + (size_t)(r0 + 96) * UC + c8),
          t4 = *(const uint4*)(Ux + (size_t)(r0 + 128) * UC + c8), t5 = *(const uint4*)(Ux + (size_t)(r0 + 160) * UC + c8),
          t6 = *(const uint4*)(Ux + (size_t)(r0 + 192) * UC + c8), t7 = *(const uint4*)(Ux + (size_t)(r0 + 224) * UC + c8);
    *(uint4*)(raw + (r0)*64 + c8) = t0;
    *(uint4*)(raw + (r0 + 32) * 64 + c8) = t1;
    *(uint4*)(raw + (r0 + 64) * 64 + c8) = t2;
    *(uint4*)(raw + (r0 + 96) * 64 + c8) = t3;
    *(uint4*)(raw + (r0 + 128) * 64 + c8) = t4;
    *(uint4*)(raw + (r0 + 160) * 64 + c8) = t5;
    *(uint4*)(raw + (r0 + 192) * 64 + c8) = t6;
    *(uint4*)(raw + (r0 + 224) * 64 + c8) = t7;
  }
  __syncthreads();
  {
    const int c = tid & 63, r0 = tid >> 6;
    const int col = cb * 64 + c;
    const float w0 = p.m2_conv_w[(l * 4 + 0) * 768 + col], w1 = p.m2_conv_w[(l * 4 + 1) * 768 + col],
                w2 = p.m2_conv_w[(l * 4 + 2) * 768 + col], w3 = p.m2_conv_w[(l * 4 + 3) * 768 + col];
    const float bias = p.m2_conv_b[l * 768 + col];
#pragma unroll 8
    for (int i = 0; i < 64; i++) {
      const int r = r0 + 4 * i;
      const int lo = span == 0 ? 0 : (r & ~63), hi = span == 0 ? 256 : (r & ~63) + 64;
      float sum = bias;
      if (r - 1 >= lo) sum += w0 * bf2f(raw[(r - 1) * 64 + c]);
      sum += w1 * bf2f(raw[r * 64 + c]);
      if (r + 1 < hi) sum += w2 * bf2f(raw[(r + 1) * 64 + c]);
      if (r + 2 < hi) sum += w3 * bf2f(raw[(r + 2) * 64 + c]);
      Ux[(size_t)r * UC + c] = f2bf(siluf_(sum));
    }
  }
  if (cb == 0) {
    for (int e = tid; e < 256 * 16; e += 256) {
      int r = e >> 4, j = e & 15;
      bf16_t* ptr = Ub + (size_t)r * UC + C_MDT + j;
      *ptr = f2bf(softplusf_(bf2f(*ptr) + p.m2_dt_bias[l * 16 + j]));
    }
  }
}

#define MS 72
__device__ void m2_stream(const Params& p, int l, int item, unsigned char* smem) {
  const int hd = item & 7, d = (item >> 3) & 1, bl = item >> 4;
  const int g2 = hd >> 2;
  bf16_t* Cm = (bf16_t*)smem;
  bf16_t* Bm = Cm + 64 * MS;
  bf16_t* Bmt = Bm + 64 * MS;
  bf16_t* Xt = Bmt + 64 * MS;
  bf16_t* Stt = Xt + 64 * MS;
  float* cumW = (float*)(Stt + 64 * MS);
  float* dtW = cumW + 64;
  float* wW = dtW + 64;
  const int tid = tid_opaque(), lane = tid & 63, wave = tid >> 6;
  bf16_t* U = p.U + (size_t)bl * TT * UC;
  const float aneg = -expf(p.m2_a_log[(l * 2 + d) * 8 + hd]);
  const float dsk = d == 0 ? p.m2_d[l * 8 + hd] : 0.f;
  const int ycol = (d == 0 ? Y_MF : Y_MB) + hd * 64;
  const int bcol = C_MX + 512 + g2 * 64, ccol = C_MX + 640 + g2 * 64, xcol = C_MX + hd * 64;
  const int dtcol = C_MDT + d * 8 + hd;
  const int r32 = lane & 31, h = lane >> 5;
  const int qa = wave >> 1, pb = wave & 1;
  const int j0 = tid >> 3, c8 = (tid & 7) * 8;
  f32x16 Sq;
#pragma unroll
  for (int r = 0; r < 16; r++) Sq[r] = 0.f;
  uint4 aB0, aB1, aC0, aC1, aX0, aX1, bB0, bB1, bC0, bC1, bX0, bX1;
  bf16_t adt, bdt;
#define M2_ROW(tau, jj) ((unsigned)(((tau)*64 + (d == 0 ? (jj) : 63 - (jj))) * UC))
#define M2_ISSUE(tau)                                            \
  {                                                              \
    const unsigned ra = M2_ROW(tau, j0), rb = M2_ROW(tau, j0 + 32); \
    rB0 = *(const uint4*)(U + ra + bcol + c8);                   \
    rB1 = *(const uint4*)(U + rb + bcol + c8);                   \
    rC0 = *(const uint4*)(U + ra + ccol + c8);                   \
    rC1 = *(const uint4*)(U + rb + ccol + c8);                   \
    rX0 = *(const uint4*)(U + ra + xcol + c8);                   \
    rX1 = *(const uint4*)(U + rb + xcol + c8);                   \
    rdt = U[M2_ROW(tau, lane) + dtcol];                          \
  }
  auto chunk = [&](const int c, uint4& rB0, uint4& rB1, uint4& rC0, uint4& rC1, uint4& rX0, uint4& rX1,
                   bf16_t& rdt) __attribute__((always_inline)) {
    const int tau = tile_of(c, d);
    {
      *(uint4*)(Bm + j0 * MS + c8) = rB0;
      *(uint4*)(Bm + (j0 + 32) * MS + c8) = rB1;
      *(uint4*)(Cm + j0 * MS + c8) = rC0;
      *(uint4*)(Cm + (j0 + 32) * MS + c8) = rC1;
      const unsigned wB0[4] = {rB0.x, rB0.y, rB0.z, rB0.w};
      const unsigned wB1[4] = {rB1.x, rB1.y, rB1.z, rB1.w};
      const unsigned wX0[4] = {rX0.x, rX0.y, rX0.z, rX0.w};
      const unsigned wX1[4] = {rX1.x, rX1.y, rX1.z, rX1.w};
#pragma unroll
      for (int q = 0; q < 4; q++) {
        Bmt[(c8 + 2 * q) * MS + j0] = (bf16_t)(wB0[q] & 0xffffu);
        Bmt[(c8 + 2 * q + 1) * MS + j0] = (bf16_t)(wB0[q] >> 16);
        Bmt[(c8 + 2 * q) * MS + j0 + 32] = (bf16_t)(wB1[q] & 0xffffu);
        Bmt[(c8 + 2 * q + 1) * MS + j0 + 32] = (bf16_t)(wB1[q] >> 16);
        Xt[(c8 + 2 * q) * MS + j0] = (bf16_t)(wX0[q] & 0xffffu);
        Xt[(c8 + 2 * q + 1) * MS + j0] = (bf16_t)(wX0[q] >> 16);
        Xt[(c8 + 2 * q) * MS + j0 + 32] = (bf16_t)(wX1[q] & 0xffffu);
        Xt[(c8 + 2 * q + 1) * MS + j0 + 32] = (bf16_t)(wX1[q] >> 16);
      }
#pragma unroll
      for (int g4 = 0; g4 < 4; g4++) {
        uint2 pk;
        pk.x = pack2bf(Sq[4 * g4], Sq[4 * g4 + 1]);
        pk.y = pack2bf(Sq[4 * g4 + 2], Sq[4 * g4 + 3]);
        *(uint2*)(Stt + (pb * 32 + r32) * MS + qa * 32 + 8 * g4 + 4 * h) = pk;
      }
      if (wave == 0) {
        const float dtv = bf2f(rdt);
        float x = dtv * aneg;
#pragma unroll
        for (int off = 1; off < 64; off <<= 1) {
          float y = __shfl_up(x, off);
          if (lane >= off) x += y;
        }
        const float ce = __shfl(x, 63);
        cumW[lane] = x;
        dtW[lane] = dtv;
        wW[lane] = __expf(ce - x) * dtv;
      }
    }
    __syncthreads();
    if (c + 2 < NTILE) M2_ISSUE(tile_of(c + 2, d))
    const float cend = cumW[63];
    {
      const int ib = qa;
      f32x16 Y;
#pragma unroll
      for (int r = 0; r < 16; r++) Y[r] = 0.f;
#pragma unroll
      for (int ks = 0; ks < 4; ks++) {
        bf16x8 a = *(const bf16x8*)(Cm + (ib * 32 + r32) * MS + ks * 16 + 8 * h);
        bf16x8 bb = *(const bf16x8*)(Stt + (pb * 32 + r32) * MS + ks * 16 + 8 * h);
        Y = __builtin_amdgcn_mfma_f32_32x32x16_bf16(a, bb, Y, 0, 0, 0);
      }
#pragma unroll
      for (int g4 = 0; g4 < 4; g4++) {
        const float4 ci = *(const float4*)(cumW + ib * 32 + 8 * g4 + 4 * h);
        Y[4 * g4] *= __expf(ci.x);
        Y[4 * g4 + 1] *= __expf(ci.y);
        Y[4 * g4 + 2] *= __expf(ci.z);
        Y[4 * g4 + 3] *= __expf(ci.w);
      }
      const float cum_i = cumW[ib * 32 + r32];
#pragma unroll 1
      for (int jb = 0; jb <= ib; jb++) {
        f32x16 G;
#pragma unroll
        for (int r = 0; r < 16; r++) G[r] = 0.f;
#pragma unroll
        for (int ks = 0; ks < 4; ks++) {
          bf16x8 a = *(const bf16x8*)(Bm + (jb * 32 + r32) * MS + ks * 16 + 8 * h);
          bf16x8 bb = *(const bf16x8*)(Cm + (ib * 32 + r32) * MS + ks * 16 + 8 * h);
          G = __builtin_amdgcn_mfma_f32_32x32x16_bf16(a, bb, G, 0, 0, 0);
        }
#pragma unroll
        for (int g4 = 0; g4 < 4; g4++) {
          const int jbase = jb * 32 + 8 * g4 + 4 * h;
          const float4 cj = *(const float4*)(cumW + jbase);
          const float4 dj = *(const float4*)(dtW + jbase);
          const float cjv[4] = {cj.x, cj.y, cj.z, cj.w};
          const float djv[4] = {dj.x, dj.y, dj.z, dj.w};
#pragma unroll
          for (int q = 0; q < 4; q++) {
            const int r = 4 * g4 + q;
            const float val = G[r] * __expf(fminf(cum_i - cjv[q], 0.f)) * djv[q];
            G[r] = (jbase + q <= ib * 32 + r32) ? val : 0.f;
          }
        }
#pragma unroll
        for (int s2 = 0; s2 < 2; s2++) {
          float t8[8];
#pragma unroll
          for (int q = 0; q < 8; q++) t8[q] = G[8 * s2 + q];
          bf16x8 a = pack_bf16x8(t8);
          const bf16_t* bp = Xt + (pb * 32 + r32) * MS + jb * 32 + 16 * s2 + 4 * h;
          uint2 lo = *(const uint2*)bp, hi = *(const uint2*)(bp + 8);
          uint4 t4 = make_uint4(lo.x, lo.y, hi.x, hi.y);
          bf16x8 bb = *(bf16x8*)&t4;
          Y = __builtin_amdgcn_mfma_f32_32x32x16_bf16(a, bb, Y, 0, 0, 0);
        }
      }
#pragma unroll
      for (int r = 0; r < 16; r++) {
        const int i = ib * 32 + (r & 3) + 8 * (r >> 2) + 4 * h;
        const float xv = bf2f(Xt[(pb * 32 + r32) * MS + i]);
        U[M2_ROW(tau, i) + ycol + pb * 32 + r32] = f2bf(Y[r] + dsk * xv);
      }
    }
    {
      const float dec = __expf(cend);
#pragma unroll
      for (int r = 0; r < 16; r++) Sq[r] *= dec;
#pragma unroll
      for (int ks = 0; ks < 4; ks++) {
        const float4 w0 = *(const float4*)(wW + ks * 16 + 8 * h);
        const float4 w1 = *(const float4*)(wW + ks * 16 + 8 * h + 4);
        bf16x8 a = *(const bf16x8*)(Bmt + (qa * 32 + r32) * MS + ks * 16 + 8 * h);
        uint4 raw = *(const uint4*)(Xt + (pb * 32 + r32) * MS + ks * 16 + 8 * h);
        float t8[8];
        unpack8(raw, t8);
        t8[0] *= w0.x; t8[1] *= w0.y; t8[2] *= w0.z; t8[3] *= w0.w;
        t8[4] *= w1.x; t8[5] *= w1.y; t8[6] *= w1.z; t8[7] *= w1.w;
        bf16x8 bb = pack_bf16x8(t8);
        Sq = __builtin_amdgcn_mfma_f32_32x32x16_bf16(a, bb, Sq, 0, 0, 0);
      }
    }
    __syncthreads();
  };
  __syncthreads();
  {
    uint4 &rB0 = aB0, &rB1 = aB1, &rC0 = aC0, &rC1 = aC1, &rX0 = aX0, &rX1 = aX1;
    bf16_t& rdt = adt;
    M2_ISSUE(tile_of(0, d))
  }
  {
    uint4 &rB0 = bB0, &rB1 = bB1, &rC0 = bC0, &rC1 = bC1, &rX0 = bX0, &rX1 = bX1;
    bf16_t& rdt = bdt;
    M2_ISSUE(tile_of(1, d))
  }
  for (int c = 0; c < NTILE; c += 2) {
    chunk(c, aB0, aB1, aC0, aC1, aX0, aX1, adt);
    chunk(c + 1, bB0, bB1, bC0, bC1, bX0, bX1, bdt);
  }
#undef M2_ROW
#undef M2_ISSUE
}

__device__ void s5_stream(const Params& p, int l, int item, unsigned char* smem) {
  const int g4 = item & 7, d = (item >> 3) & 1, bl = item >> 4;
  const int tid = tid_opaque(), lane = tid & 63, wave = tid >> 6;
  const int g = g4 * 4 + wave;
  bf16_t* buT = (bf16_t*)(smem + wave * 18944);
  unsigned* st = (unsigned*)(smem + wave * 18944 + 10240);
  bf16_t* U = p.U + (size_t)bl * TT * UC;
  const float* pbase = p.s5p + (size_t)(((l * 2 + d) * 32 + g) * 64) * 34;
  const float are = pbase[lane * 34], aim = pbase[lane * 34 + 1];
  const int kq = lane >> 4, c16 = lane & 15;
  bf16x8 bfB[8];
#pragma unroll
  for (int cb = 0; cb < 8; cb++) {
    const int kk = cb * 16 + c16;
    const float* pr = pbase + (kk >> 1) * 34 + ((kk & 1) ? 18 : 2);
#pragma unroll
    for (int j = 0; j < 8; j++) {
      float v = pr[(8 * kq + j) & 15];
      bfB[cb][j] = (short)f2bf(kq < 2 ? v : 0.f);
    }
  }
  bf16x8 cf[4];
  {
    const float* cre = p.s5_c_re + ((size_t)(l * 32 + g) * 16 + c16) * 64;
    const float* cim = p.s5_c_im + ((size_t)(l * 32 + g) * 16 + c16) * 64;
#pragma unroll
    for (int ks = 0; ks < 4; ks++) {
#pragma unroll
      for (int j = 0; j < 8; j++) {
        int kk = 8 * kq + 32 * ks + j;
        int n = kk >> 1;
        float val = (kk & 1) ? -cim[n] : cre[n];
        cf[ks][j] = (short)f2bf(val);
      }
    }
  }
  __syncthreads();
  float sre = 0.f, sim = 0.f;
  const int ucol = C_SU + g * 16 + (kq & 1) * 8;
  const int ycol = (d == 0 ? Y_SF : Y_SB) + g * 16;
#define S5_ROW(sb, jj) ((unsigned)((tile_of((sb) >> 1, d) * 64 + (d == 0 ? (((sb)&1) * 32 + (jj)) : 63 - (((sb)&1) * 32 + (jj)))) * UC))
  uint4 ru0 = *(const uint4*)(U + S5_ROW(0, c16) + ucol);
  uint4 ru1 = *(const uint4*)(U + S5_ROW(0, 16 + c16) + ucol);
  for (int sb = 0; sb < 2 * NTILE; sb++) {
    uint4 cur0 = ru0, cur1 = ru1;
    if (kq >= 2) { cur0 = make_uint4(0u, 0u, 0u, 0u); cur1 = cur0; }
    const bf16x8 af0 = *(bf16x8*)&cur0;
    const bf16x8 af1 = *(bf16x8*)&cur1;
    __builtin_amdgcn_wave_barrier();
#pragma unroll
    for (int cb = 0; cb < 8; cb++) {
      f32x4 a0 = {0.f, 0.f, 0.f, 0.f}, a1 = {0.f, 0.f, 0.f, 0.f};
      a0 = __builtin_amdgcn_mfma_f32_16x16x32_bf16(af0, bfB[cb], a0, 0, 0, 0);
      a1 = __builtin_amdgcn_mfma_f32_16x16x32_bf16(af1, bfB[cb], a1, 0, 0, 0);
      uint2 w0, w1;
      w0.x = pack2bf(a0[0], a0[1]); w0.y = pack2bf(a0[2], a0[3]);
      w1.x = pack2bf(a1[0], a1[1]); w1.y = pack2bf(a1[2], a1[3]);
      *(uint2*)(buT + (cb * 16 + c16) * 40 + 4 * kq) = w0;
      *(uint2*)(buT + (cb * 16 + c16) * 40 + 16 + 4 * kq) = w1;
    }
    if (sb + 1 < 2 * NTILE) {
      ru0 = *(const uint4*)(U + S5_ROW(sb + 1, c16) + ucol);
      ru1 = *(const uint4*)(U + S5_ROW(sb + 1, 16 + c16) + ucol);
    }
    __builtin_amdgcn_wave_barrier();
    {
      float bre[32], bim[32];
#pragma unroll
      for (int q = 0; q < 4; q++) {
        const uint4 r = *(const uint4*)(buT + (2 * lane) * 40 + 8 * q);
        const uint4 m = *(const uint4*)(buT + (2 * lane + 1) * 40 + 8 * q);
        const unsigned rw[4] = {r.x, r.y, r.z, r.w};
        const unsigned mw[4] = {m.x, m.y, m.z, m.w};
#pragma unroll
        for (int e = 0; e < 4; e++) {
          bre[8 * q + 2 * e] = __uint_as_float(rw[e] << 16);
          bre[8 * q + 2 * e + 1] = __uint_as_float(rw[e] & 0xffff0000u);
          bim[8 * q + 2 * e] = __uint_as_float(mw[e] << 16);
          bim[8 * q + 2 * e + 1] = __uint_as_float(mw[e] & 0xffff0000u);
        }
      }
#pragma unroll
      for (int jj = 0; jj < 32; jj++) {
        const float nr = are * sre - aim * sim + bre[jj];
        const float ni = are * sim + aim * sre + bim[jj];
        sre = nr;
        sim = ni;
        st[jj * 68 + lane] = pack2bf(sre, sim);
      }
    }
    __builtin_amdgcn_wave_barrier();
#pragma unroll
    for (int tb = 0; tb < 2; tb++) {
      f32x4 acc = {0.f, 0.f, 0.f, 0.f};
#pragma unroll
      for (int ks = 0; ks < 4; ks++) {
        bf16x8 a = *(const bf16x8*)((const unsigned char*)st + (tb * 16 + c16) * 272 + (8 * kq + 32 * ks) * 2);
        acc = __builtin_amdgcn_mfma_f32_16x16x32_bf16(a, cf[ks], acc, 0, 0, 0);
      }
#pragma unroll
      for (int i = 0; i < 4; i++) U[S5_ROW(sb, tb * 16 + 4 * kq + i) + ycol + c16] = f2bf(acc[i]);
    }
  }
#undef S5_ROW
}

__device__ void lru_prep(const Params& p, int l, int item, unsigned char* smem) {
  const int n = item & 7, tau = (item >> 3) % NTILE, bl = (item >> 3) / NTILE;
  bf16_t* Wt = (bf16_t*)smem;
  bf16_t* xc = Wt + 4 * 64 * 72;
  bf16_t* raw = xc + 64 * 72;
  bf16_t* U = p.U + (size_t)bl * TT * UC;
  const int tid = tid_opaque(), lane = tid & 63, wave = tid >> 6;
  const int d = wave >> 1, half = wave & 1;
  __syncthreads();
  {
    uint4 w8[8];
#pragma unroll
    for (int i = 0; i < 8; i++) {
      const int e = tid + 256 * i;
      const int dg = e >> 9, dout = (e >> 3) & 63, c8 = (e & 7) * 8;
      w8[i] = *(const uint4*)(p.Wlru + ((size_t)((l * 4 + dg) * 8 + n) * 64 + dout) * 64 + c8);
    }
    uint4 x3[3];
#pragma unroll
    for (int i = 0; i < 3; i++) {
      const int e = tid + 256 * i;
      const int rr = e >> 3, c8 = (e & 7) * 8;
      const int tt = rr - 1;
      const bool ok = (e < 67 * 8) && ((tau < 4) ? ((tau * 64 + tt) >= 0 && (tau * 64 + tt) < CTXL) : (tt >= 0 && tt < 64));
      x3[i] = make_uint4(0u, 0u, 0u, 0u);
      if (ok) x3[i] = *(const uint4*)(U + (size_t)(tau * 64 + tt) * UC + C_LX + n * 64 + c8);
    }
#pragma unroll
    for (int i = 0; i < 8; i++) {
      const int e = tid + 256 * i;
      const int dg = e >> 9, dout = (e >> 3) & 63, c8 = (e & 7) * 8;
      *(uint4*)(Wt + (dg * 64 + dout) * 72 + c8) = w8[i];
    }
#pragma unroll
    for (int i = 0; i < 3; i++) {
      const int e = tid + 256 * i;
      const int rr = e >> 3, c8 = (e & 7) * 8;
      if (e < 67 * 8) *(uint4*)(raw + rr * 64 + c8) = x3[i];
    }
  }
  __syncthreads();
  {
    const int cc = tid & 63, t0 = tid >> 6;
    const float* cw = p.lru_conv_w + (size_t)l * 4 * 512 + n * 64 + cc;
    const float w0 = cw[0], w1 = cw[512], w2 = cw[1024], w3 = cw[1536];
    const float bias = p.lru_conv_b[l * 512 + n * 64 + cc];
#pragma unroll 4
    for (int i = 0; i < 16; i++) {
      const int ti = t0 + 4 * i;
      float sum = bias + w0 * bf2f(raw[(ti)*64 + cc]) + w1 * bf2f(raw[(ti + 1) * 64 + cc]) +
                  w2 * bf2f(raw[(ti + 2) * 64 + cc]) + w3 * bf2f(raw[(ti + 3) * 64 + cc]);
      xc[ti * 72 + cc] = f2bf(sum);
    }
  }
  __syncthreads();
  const int dout = half * 32 + (lane & 31);
  const int ch = n * 64 + dout;
  const float gbr = p.lru_gate_b[(((l * 2 + d) * 2 + 0) * 8 + n) * 64 + dout];
  const float gbi = p.lru_gate_b[(((l * 2 + d) * 2 + 1) * 8 + n) * 64 + dout];
  const float spl = softplusf_(-p.lru_lam[(l * 2 + d) * 512 + ch]);
  const int r32 = lane & 31, kh = (lane >> 5) * 8;
  f32x16 acc[2][2];
#pragma unroll
  for (int i = 0; i < 2; i++)
#pragma unroll
    for (int j = 0; j < 2; j++)
#pragma unroll
      for (int r = 0; r < 16; r++) acc[i][j][r] = 0.f;
#pragma unroll
  for (int ks = 0; ks < 4; ks++) {
    bf16x8 a0 = *(const bf16x8*)(xc + (r32)*72 + ks * 16 + kh);
    bf16x8 a1 = *(const bf16x8*)(xc + (32 + r32) * 72 + ks * 16 + kh);
#pragma unroll
    for (int gt = 0; gt < 2; gt++) {
      bf16x8 b = *(const bf16x8*)(Wt + ((d * 2 + gt) * 64 + half * 32 + r32) * 72 + ks * 16 + kh);
      acc[0][gt] = __builtin_amdgcn_mfma_f32_32x32x16_bf16(a0, b, acc[0][gt], 0, 0, 0);
      acc[1][gt] = __builtin_amdgcn_mfma_f32_32x32x16_bf16(a1, b, acc[1][gt], 0, 0, 0);
    }
  }
#pragma unroll
  for (int tb = 0; tb < 2; tb++)
#pragma unroll
    for (int reg = 0; reg < 16; reg++) {
      int tok = tb * 32 + (reg & 3) + 8 * (reg >> 2) + 4 * (lane >> 5);
      float r = sigmoidf_(acc[tb][0][reg] + gbr);
      float ig = sigmoidf_(acc[tb][1][reg] + gbi);
      float la = -8.f * r * spl;
      float bc = sqrtf(fmaxf(1.f - __expf(2.f * la), 0.f));
      float xv = bf2f(xc[tok * 72 + dout]);
      unsigned ro = (unsigned)((tau * 64 + tok) * UC);
      U[ro + (d == 0 ? L_LAF : L_LAB) + ch] = f2bf(la);
      U[ro + (d == 0 ? Y_LF : Y_LB) + ch] = f2bf(bc * ig * xv);
    }
}

__device__ void lru_scan(const Params& p, int item, unsigned char* smem) {
  const int cgp = item & 15, d = (item >> 4) & 1, bl = item >> 5;
  const int tid = tid_opaque(), cl = tid & 31, seg = tid >> 5;
  const int ch = cgp * 32 + cl;
  float* sA = (float*)smem;
  float* sH = sA + 256;
  bf16_t* U = p.U + (size_t)bl * TT * UC;
  const int lacol = (d == 0 ? L_LAF : L_LAB) + ch;
  const int ycol = (d == 0 ? Y_LF : Y_LB) + ch;
#define LRU_ROW(s_) ((size_t)(d == 0 ? (s_) : ((s_) < 256 ? 255 - (s_) : 4607 - (s_))) * UC)
  float A = 1.f, hh = 0.f;
  for (int s0 = seg * 544; s0 < seg * 544 + 544; s0 += 32) {
    float la[32], bx[32];
#pragma unroll
    for (int i = 0; i < 32; i++) {
      const size_t ro = LRU_ROW(s0 + i);
      la[i] = bf2f(U[ro + lacol]);
      bx[i] = bf2f(U[ro + ycol]);
    }
#pragma unroll
    for (int i = 0; i < 32; i++) {
      const float a = __expf(la[i]);
      A *= a;
      hh = a * hh + bx[i];
    }
  }
  __syncthreads();
  sA[seg * 32 + cl] = A;
  sH[seg * 32 + cl] = hh;
  __syncthreads();
  float h0 = 0.f;
  for (int s2 = 0; s2 < seg; s2++) h0 = sA[s2 * 32 + cl] * h0 + sH[s2 * 32 + cl];
  hh = h0;
  for (int s0 = seg * 544; s0 < seg * 544 + 544; s0 += 32) {
    float la[32], bx[32];
#pragma unroll
    for (int i = 0; i < 32; i++) {
      const size_t ro = LRU_ROW(s0 + i);
      la[i] = bf2f(U[ro + lacol]);
      bx[i] = bf2f(U[ro + ycol]);
    }
#pragma unroll
    for (int i = 0; i < 32; i++) {
      hh = __expf(la[i]) * hh + bx[i];
      U[LRU_ROW(s0 + i) + ycol] = f2bf(hh);
    }
  }
#undef LRU_ROW
}

__device__ void finalize_row(const Params& p, int l, int r) {
  const int tid = tid_opaque();
  const int lane = tid & 63;
  bf16_t* row = p.U + (size_t)r * UC;
  const int c0 = lane * 8;
  const uint4 uHF = *(const uint4*)(row + Y_HF + c0), uHB = *(const uint4*)(row + Y_HB + c0),
              uHZ = *(const uint4*)(row + C_HZ + c0), uSF = *(const uint4*)(row + Y_SF + c0),
              uSB = *(const uint4*)(row + Y_SB + c0), uSU = *(const uint4*)(row + C_SU + c0),
              uMF = *(const uint4*)(row + Y_MF + c0), uMB = *(const uint4*)(row + Y_MB + c0),
              uMZ = *(const uint4*)(row + C_MZ + c0), uLF = *(const uint4*)(row + Y_LF + c0),
              uLB = *(const uint4*)(row + Y_LB + c0), uLZ = *(const uint4*)(row + C_LZ + c0);
  float a[8], b[8], z[8], o[8];
  unpack8(uHF, a); unpack8(uHB, b); unpack8(uHZ, z);
  float ss = 0.f;
#pragma unroll
  for (int i = 0; i < 8; i++) {
    a[i] += b[i];
    ss += a[i] * a[i];
  }
  ss += __shfl_xor(ss, 1);
  ss += __shfl_xor(ss, 2);
  ss += __shfl_xor(ss, 4);
  ss += __shfl_xor(ss, 8);
  float rstd = rsqrtf(ss * (1.f / 128.f) + EPS);
  {
    const float4 n0 = *(const float4*)(p.hg_norm + l * 512 + c0), n1 = *(const float4*)(p.hg_norm + l * 512 + c0 + 4);
    const float nw[8] = {n0.x, n0.y, n0.z, n0.w, n1.x, n1.y, n1.z, n1.w};
#pragma unroll
    for (int i = 0; i < 8; i++) o[i] = a[i] * rstd * nw[i] * siluf_(z[i]);
  }
  store8(row + Y_HF + c0, o);
  unpack8(uSF, a); unpack8(uSB, b); unpack8(uSU, z);
  {
    const float4 n0 = *(const float4*)(p.s5_d + l * 512 + c0), n1 = *(const float4*)(p.s5_d + l * 512 + c0 + 4);
    const float nw[8] = {n0.x, n0.y, n0.z, n0.w, n1.x, n1.y, n1.z, n1.w};
#pragma unroll
    for (int i = 0; i < 8; i++) o[i] = geluf_(a[i] + b[i] + nw[i] * z[i]);
  }
  store8(row + Y_SF + c0, o);
  unpack8(uMF, a); unpack8(uMB, b); unpack8(uMZ, z);
  ss = 0.f;
#pragma unroll
  for (int i = 0; i < 8; i++) {
    a[i] = (a[i] + b[i]) * siluf_(z[i]);
    ss += a[i] * a[i];
  }
#pragma unroll
  for (int m = 1; m < 64; m <<= 1) ss += __shfl_xor(ss, m);
  rstd = rsqrtf(ss * (1.f / 512.f) + EPS);
  {
    const float4 n0 = *(const float4*)(p.m2_norm + l * 512 + c0), n1 = *(const float4*)(p.m2_norm + l * 512 + c0 + 4);
    const float nw[8] = {n0.x, n0.y, n0.z, n0.w, n1.x, n1.y, n1.z, n1.w};
#pragma unroll
    for (int i = 0; i < 8; i++) o[i] = a[i] * rstd * nw[i];
  }
  store8(row + Y_MF + c0, o);
  unpack8(uLF, a); unpack8(uLB, b); unpack8(uLZ, z);
#pragma unroll
  for (int i = 0; i < 8; i++) o[i] = (a[i] + b[i]) * siluf_(z[i]);
  store8(row + Y_LF + c0, o);
}

__device__ void phase_prep(const Params& p, int l, unsigned char* smem) {
  const int total = 2176 + 2176 + 816;
  for (int it = blockIdx.x; it < total; it += gridDim.x) {
    if (it < 2176) lru_prep(p, l, it, smem);
    else if (it < 4352) hg_prep(p, l, it - 2176, smem);
    else m2_prep(p, l, it - 4352, smem);
  }
}

__device__ void phase_scan(const Params& p, int l, unsigned char* smem, int mask, unsigned* zctr) {
  const int total = 64 + 64 + 128 + 128;
  for (int it = blockIdx.x; it < total; it += gridDim.x) {
    if (it < 64) {
      const int xc = it & 7, slot = it >> 3;
      const int gidx = xc * 2 + (slot >> 2);
      const int item = ((gidx >> 1) << 3) | ((gidx & 1) * 4 + (slot & 3));
      if (mask & 1) m2_stream(p, l, item, smem);
    }
    else if (it < 128) { if (mask & 2) s5_stream(p, l, it - 64, smem); }
    else if (it < 256) {
      const int b2 = it - 128, xc = b2 & 7, slot = b2 >> 3;
      const int item = (xc * 4 + (slot >> 2)) * 4 + (slot & 3);
      if (mask & 4) hg_stream(p, l, item, smem);
    }
    else { if (mask & 8) lru_scan(p, it - 256, smem); }
  }
  if (zctr) zgate_tiles(p, l, zctr, smem);
}

__device__ void phase_fin1(const Params& p, int l) {
  const int tid = tid_opaque();
  if (l == 0) {
    const int total = RG / 4;
    for (int it = blockIdx.x; it < total; it += gridDim.x) finalize_row(p, l, it * 4 + (tid >> 6));
  } else {
    const int total = GB * SEQ / 4;
    for (int it = blockIdx.x; it < total; it += gridDim.x) {
      const int q = it * 4 + (tid >> 6);
      finalize_row(p, l, (q >> 12) * TT + CTXL + (q & 4095));
    }
  }
}

__device__ void phase_fin2(const Params& p, int l, unsigned char* smem) {
  const int tid = tid_opaque();
  const int ntm = RG / 128;
  const int n_glu = (l == 0 ? ntm : 128) * 4;
  const int total = n_glu;
  const bf16_t* Wt = p.W + (size_t)l * W_LAYER + W_GLU_OFF;
  for (int it = blockIdx.x; it < total; it += gridDim.x) {
    if (it < n_glu) {
      int tm, tn;
      if (l == 0) { tm = it % ntm; tn = it / ntm; }
      else { const int tml = it & 127; tn = it >> 7; tm = (tml >> 5) * 34 + 2 + (tml & 31); }
      f32x16 acc[2][2];
      acc_zero<2, 2>(acc);
      gemm_main<2, 2>(p.U + (size_t)tm * 128 * UC + Y_SF, UC, Wt + (size_t)tn * 128 * 512, 512, 512, acc, smem);
#pragma unroll
      for (int i = 0; i < 2; i++)
#pragma unroll
        for (int jn = 0; jn < 2; jn++)
#pragma unroll
          for (int reg = 0; reg < 16; reg++) {
            int row = tm * 128 + ACC_ROW(i, reg), col = tn * 128 + ACC_COL(2, jn);
            bf16_t* rp = p.U + (size_t)row * UC;
            float gv = bf2f(rp[Y_SF + col]);
            float zv = bf2f(rp[C_SZ + col]);
            float val = gv * sigmoidf_(acc[i][jn][reg] + p.s5_b_glu[l * 512 + col]) * siluf_(zv);
            rp[Y_SB + col] = f2bf(val);
          }
    }
  }
}

template <int TN>
__device__ __forceinline__ void merge_tile(const Params& p, int l, int tm, int tn, unsigned char* smem) {
  const int tid = tid_opaque();
  constexpr int BN = 64 * TN;
  const bf16_t* Wl = p.W + (size_t)l * W_LAYER;
  f32x16 macc[2][TN];
  acc_zero<2, TN>(macc);
#pragma unroll 1
  for (int k = 0; k < 4; k++) {
    f32x16 acc[2][TN];
    acc_zero<2, TN>(acc);
    gemm_main<2, TN, false>(p.H + ((size_t)tm * 128) * 1024, 1024, Wl + W_G_OFF + ((size_t)k * 1024 + tn * BN) * 1024,
                               1024, 1024, acc, smem);
    unsigned sg[2][TN][4];
#pragma unroll
    for (int jn = 0; jn < TN; jn++) {
      const float bg = p.b_gate[(l * 4 + k) * 1024 + tn * BN + ACC_COL(TN, jn)];
#pragma unroll
      for (int i = 0; i < 2; i++)
#pragma unroll
        for (int r4 = 0; r4 < 4; r4++) {
          unsigned w = 0;
#pragma unroll
          for (int q = 0; q < 4; q++) {
            const float sv = sigmoidf_(acc[i][jn][4 * r4 + q] + bg);
            w |= ((unsigned)(sv * 255.f + 0.5f)) << (8 * q);
          }
          sg[i][jn][r4] = w;
        }
    }
    acc_zero<2, TN>(acc);
    const int yc = k == 0 ? Y_HF : (k == 1 ? Y_SB : (k == 2 ? Y_LF : Y_MF));
    gemm_main<2, TN, false>(p.U + (size_t)tm * 128 * UC + yc, UC, Wl + W_B_OFF + ((size_t)k * 1024 + tn * BN) * 512, 512,
                               512, acc, smem);
#pragma unroll
    for (int i = 0; i < 2; i++)
#pragma unroll
      for (int jn = 0; jn < TN; jn++)
#pragma unroll
        for (int r4 = 0; r4 < 4; r4++) {
          const unsigned w = sg[i][jn][r4];
#pragma unroll
          for (int q = 0; q < 4; q++)
            macc[i][jn][4 * r4 + q] += (float)((w >> (8 * q)) & 0xffu) * (1.f / 255.f) * acc[i][jn][4 * r4 + q];
        }
  }
#pragma unroll
  for (int i = 0; i < 2; i++)
#pragma unroll
    for (int jn = 0; jn < TN; jn++)
#pragma unroll
      for (int reg = 0; reg < 16; reg++) {
        int row = tm * 128 + ACC_ROW(i, reg), col = tn * BN + ACC_COL(TN, jn);
        p.U[(size_t)row * UC + col] = f2bf(macc[i][jn][reg]);
      }
}

__device__ void phase_merge(const Params& p, int l, int g, unsigned char* smem) {
  const int n_lat = 128 * 8;
  const int total = n_lat + (l == 0 ? 128 : 0);
  for (int it = blockIdx.x; it < total; it += gridDim.x) {
    if (it < n_lat) {
      const int tml = it % 128, tn = it / 128;
      const int tm = (tml >> 5) * 34 + 2 + (tml & 31);
      merge_tile<2>(p, l, tm, tn, smem);
    } else {
      const int i2 = it - n_lat;
      const int tmc = i2 & 7, tn = i2 >> 3;
      const int tm = (tmc >> 1) * 34 + (tmc & 1);
      merge_tile<1>(p, l, tm, tn, smem);
    }
  }
  (void)g;
}

__device__ void phase_out(const Params& p, int l, int g, unsigned char* smem) {
  const int tid = tid_opaque();
  const int ntm = RG / 128, ntn = 8;
  const bf16_t* Wt = p.W + (size_t)l * W_LAYER + W_O_OFF;
  const int total = (l == 0) ? ntm * ntn : 128 * ntn;
  for (int it = blockIdx.x; it < total; it += gridDim.x) {
    int tm, tn;
    if (l == 0) { tm = it % ntm; tn = it / ntm; }
    else { const int tml = it & 127; tn = it >> 7; tm = (tml >> 5) * 34 + 2 + (tml & 31); }
    f32x16 acc[2][2];
    acc_zero<2, 2>(acc);
    gemm_main<2, 2>(p.U + (size_t)tm * 128 * UC, UC, Wt + (size_t)tn * 128 * 1024, 1024, 1024, acc, smem);
#pragma unroll
    for (int i = 0; i < 2; i++)
#pragma unroll
      for (int jn = 0; jn < 2; jn++)
#pragma unroll
        for (int reg = 0; reg < 16; reg++) {
          int R = g * RG + tm * 128 + ACC_ROW(i, reg), col = tn * 128 + ACC_COL(2, jn);
          int b = R / TT, t = R % TT;
          float v = acc[i][jn][reg];
          if (t < CTXL) {
            if (l == 0) {
              size_t idx = (size_t)(b * CTXL + t) * 1024 + col;
              p.ctx1[idx] = p.ctx[idx] + p.mod[(size_t)(l * 9 + 8) * 3072 + 2048 + col] * v;
            }
          } else {
            size_t idx = (size_t)(b * SEQ + t - CTXL) * 1024 + col;
            float gt = p.mod[(size_t)(l * 9 + b) * 3072 + 2048 + col];
            float base = (l == 0) ? p.x[idx] : p.out[idx];
            p.out[idx] = base + gt * v;
          }
        }
  }
}

__device__ void phase_final(const Params& p) {
  const int tid = tid_opaque();
  const int lane = tid & 63, wave = tid >> 6;
  for (int it = blockIdx.x; it < NB * SEQ / 4; it += gridDim.x) {
    int r = it * 4 + wave;
    float* src = p.out + (size_t)r * 1024;
    float4 v[4];
    float ss = 0.f;
#pragma unroll
    for (int i = 0; i < 4; i++) {
      v[i] = *(const float4*)(src + i * 256 + lane * 4);
      ss += v[i].x * v[i].x + v[i].y * v[i].y + v[i].z * v[i].z + v[i].w * v[i].w;
    }
#pragma unroll
    for (int m = 1; m < 64; m <<= 1) ss += __shfl_xor(ss, m);
    float rstd = rsqrtf(ss * (1.f / 1024.f) + EPS);
#pragma unroll
    for (int i = 0; i < 4; i++) {
      int c0 = i * 256 + lane * 4;
      float4 w = *(const float4*)(p.final_norm + c0);
      float4 o;
      o.x = v[i].x * rstd * w.x;
      o.y = v[i].y * rstd * w.y;
      o.z = v[i].z * rstd * w.z;
      o.w = v[i].w * rstd * w.w;
      *(float4*)(src + c0) = o;
    }
  }
}

#define XB_TMO      128
#define XB_XCNT(j)  (256  + 64 * (j))
#define XB_XSUB(j)  (1280 + 64 * (j))
#define XB_XGEN(j)  (2304 + 64 * (j))
#define XB_TOP      3328
#define XB_TOPGEN   3392
#define XCD_BAR_WORDS 3456
#define XB_SPIN_CAP (1u << 18)
#define LAS __attribute__((address_space(3)))

__device__ __forceinline__ unsigned xb_ld(unsigned* p)              { return __hip_atomic_load(p, __ATOMIC_RELAXED, __HIP_MEMORY_SCOPE_AGENT); }
__device__ __forceinline__ unsigned xb_add(unsigned* p, unsigned v) { return __hip_atomic_fetch_add(p, v, __ATOMIC_RELAXED, __HIP_MEMORY_SCOPE_AGENT); }
__device__ __forceinline__ unsigned xb_xcc_id() { return (unsigned)__builtin_amdgcn_s_getreg((3 << 11) | 20) & 0xFu; }
#define XB_SPIN(cond, bar) do { unsigned _sp = 0; while (cond) { __builtin_amdgcn_s_sleep(1); \
    if ((++_sp & 255u) == 0u) { if (xb_ld(&(bar)[XB_TMO])) break; if (_sp > XB_SPIN_CAP) { atomicAdd(&(bar)[XB_TMO], 1u); break; } } } } while (0)

struct XcdBarrier {
    unsigned* bar; unsigned x;
    volatile LAS unsigned* st;
};

__device__ __forceinline__ XcdBarrier xcd_barrier_post(unsigned* bar, volatile LAS unsigned* st) {
    XcdBarrier b; b.bar = bar; b.x = xb_xcc_id(); b.st = st;
    if (threadIdx.x == 0) (void)xb_add(&bar[XB_XCNT(b.x)], 1u);
    return b;
}
__device__ __forceinline__ void xcd_barrier_complete(unsigned* bar, unsigned x, unsigned& nloc, unsigned& nx) {
    const unsigned G = gridDim.x * gridDim.y * gridDim.z;
    unsigned sum, cnt, mine, sp = 0u;
    for (;;) {
        sum = 0u; cnt = 0u; mine = 0u;
#pragma unroll
        for (unsigned j = 0; j < 16; ++j) { const unsigned c = xb_ld(&bar[XB_XCNT(j)]); sum += c; cnt += (c > 0u) ? 1u : 0u; mine = (j == x) ? c : mine; }
        if (sum == G) break;
        __builtin_amdgcn_s_sleep(1);
        if ((++sp & 255u) == 0u) { if (xb_ld(&bar[XB_TMO])) break; if (sp > XB_SPIN_CAP) { atomicAdd(&bar[XB_TMO], 1u); break; } }
    }
    nloc = mine > 0u ? mine : 1u; nx = cnt > 0u ? cnt : 1u;
}

__device__ __forceinline__ void xcd_barrier(const XcdBarrier& b) {
    asm volatile("s_waitcnt vmcnt(0)" ::: "memory");
    __syncthreads();
    if (threadIdx.x == 0) {
        unsigned* bar = b.bar;
        __builtin_amdgcn_s_waitcnt(0);
        unsigned nloc = b.st[0], nx = b.st[1];
        if (nloc == 0u) { xcd_barrier_complete(bar, b.x, nloc, nx); b.st[0] = nloc; b.st[1] = nx; }
        const unsigned old = xb_add(&bar[XB_XSUB(b.x)], 1u);
        const unsigned gen = old / nloc;
        if (old + 1u == (gen + 1u) * nloc) {
            __builtin_amdgcn_fence(__ATOMIC_RELEASE, "agent");
            asm volatile("s_waitcnt vmcnt(0)" ::: "memory");
            const unsigned og = xb_add(&bar[XB_TOP], 1u);
            const unsigned tg = og / nx;
            if (og + 1u == (tg + 1u) * nx) xb_add(&bar[XB_TOPGEN], 1u);
            else XB_SPIN(xb_ld(&bar[XB_TOPGEN]) == tg, bar);
            __builtin_amdgcn_fence(__ATOMIC_ACQUIRE, "agent");
            xb_add(&bar[XB_XGEN(b.x)], 1u);
            asm volatile("s_waitcnt vmcnt(0)" ::: "memory");
        } else {
            XB_SPIN(xb_ld(&bar[XB_XGEN(b.x)]) == gen, bar);
            __builtin_amdgcn_fence(__ATOMIC_ACQUIRE, "agent");
            asm volatile("s_waitcnt vmcnt(0)" ::: "memory");
        }
    }
    __syncthreads();
}


#ifndef PH
#define PH 0xff
#endif
#define REP_INPROJ 1
#define REP_SCAN 0
#define REP_MERGE 1
__global__ void __launch_bounds__(256, 2) mega_kernel(Params p) {
  __shared__ __attribute__((aligned(16))) unsigned char smem[SMEM_BYTES];
  __shared__ uint4 xb_words;
  cg::grid_group grid = cg::this_grid();
  if (threadIdx.x == 0) xb_words = make_uint4(0u, 0u, 0u, 0u);
  __syncthreads();
  XcdBarrier xb = xcd_barrier_post(p.bar, (volatile LAS unsigned*)&xb_words);
#pragma unroll 1
  for (int step = 0; step < 31; step++) {
    int l = 0, g = 0, ph;
    if (step == 0) ph = 0;
    else if (step == 1) ph = 1;
    else if (step == 30) ph = 9;
    else {
      int s2 = step - 2;
      int lg = s2 / 7;
      l = lg >> 1;
      g = lg & 1;
      ph = 2 + (s2 % 7);
    }
    switch (ph) {
      case 0: phase0(p, smem); break;
      case 1: phase_norm(p, 0, 0); break;
      case 2: for (int rr = 0; rr < REP_INPROJ; rr++) phase_inproj(p, l, g, smem); break;
      case 3: phase_prep(p, l, smem); break;
      case 4: phase_scan(p, l, smem, 15, p.bar + XCD_BAR_WORDS + 64 * (l * 2 + g)); break;
      case 5: phase_fin1(p, l); break;
      case 6: phase_fin2(p, l, smem); break;
      case 7: for (int rr = 0; rr < REP_MERGE; rr++) phase_merge(p, l, g, smem); break;
      case 8:
        phase_out(p, l, g, smem);
        if (!(l == 1 && g == 1)) phase_norm(p, g == 1 ? l + 1 : l, g ^ 1);
        break;
      default: phase_final(p); break;
    }
    if (step == 0) grid.sync();
    else if (step != 30) xcd_barrier(xb);
  }
}

extern "C" void kernel_launch(void* const* d_in, const int* in_sizes, int n_in, void* d_out, int out_size, void* d_ws,
                              size_t ws_size, hipStream_t stream) {
  static int grid_blocks = 0;
  if (!grid_blocks) {
    int dev = 0, cus = 0, per_cu = 0;
    hipGetDevice(&dev);
    hipDeviceGetAttribute(&cus, hipDeviceAttributeMultiprocessorCount, dev);
    hipOccupancyMaxActiveBlocksPerMultiprocessor(&per_cu, mega_kernel, 256, 0);
    if (per_cu > 2) per_cu = 2;
    if (per_cu < 1) per_cu = 1;
    grid_blocks = cus * per_cu;
  }
  Params p{};
  const float** pp = (const float**)&p;
  for (int i = 0; i < 36; i++) pp[i] = (const float*)d_in[i];
  p.out = (float*)d_out;
  unsigned char* ws = (unsigned char*)d_ws;
  size_t off = 0;
  p.U = (bf16_t*)(ws + off);
  off += (size_t)RG * UC * 2;
  p.H = (bf16_t*)(ws + off);
  off += (size_t)RG * 1024 * 2;
  p.KS = (bf16_t*)(ws + off);
  off += (size_t)RG * 1024 * 2;
  p.EM = (float*)(ws + off);
  off += (size_t)GB * 2 * 4 * NTILE * 128 * 4;
  p.W = (bf16_t*)(ws + off);
  off += (size_t)2 * W_LAYER * 2;
  p.ctx1 = (float*)(ws + off);
  off += (size_t)NB * CTXL * 1024 * 4;
  p.mod = (float*)(ws + off);
  off += (size_t)2 * 9 * 3072 * 4;
  p.lb = (float*)(ws + off);
  off += (size_t)2 * 1024 * 4;
  p.s5p = (float*)(ws + off);
  off += (size_t)8192 * 34 * 4;
  p.Wlru = (bf16_t*)(ws + off);
  off += (size_t)64 * 4096 * 2;
  p.bar = (unsigned*)(ws + off);
  off += (size_t)(XCD_BAR_WORDS + 256) * 4;
  hipMemsetAsync(p.bar, 0, (size_t)(XCD_BAR_WORDS + 256) * 4, stream);
  if (off > ws_size) fprintf(stderr, "workspace too small: need %zu have %zu\n", off, ws_size);
  void* args[] = {&p};
  hipError_t e = hipLaunchCooperativeKernel((void*)mega_kernel, dim3(grid_blocks), dim3(256), args, 0, stream);
  if (e != hipSuccess) fprintf(stderr, "cooperative launch failed: %s (grid %d)\n", hipGetErrorString(e), grid_blocks);
}
```
